# Optimizing an MI355X kernel written in HIP

```python
import math
import jax, jax.numpy as jnp
from jax import lax
import numpy as np

D_MODEL = 1024
BATCH = 16
SEQ = 2048
DEPTH = 1

CHUNK = 64
MIX_WIDTH = D_MODEL
POOL_WIDTH = MIX_WIDTH // 2
POOL_WINDOWS = (2, 4, 8, 16)
POOL_GROUPS = len(POOL_WINDOWS)
POOL_GROUP_DIM = POOL_WIDTH // POOL_GROUPS
DN_WIDTH = MIX_WIDTH - POOL_WIDTH
DN_HEADS = 4
DN_HEAD_DIM = DN_WIDTH // DN_HEADS
CONV_K = 4
IN_COLS = POOL_WIDTH + 4 * DN_WIDTH + 2 * DN_HEADS
MEM_LEN = 256
XA_HEADS = 4
XA_HEAD_DIM = D_MODEL // XA_HEADS
D_FF = 4 * D_MODEL
EPS = 1e-6

kernel_name = "hymba_pool_gdn_memxattn_layer"


def rmsnorm(x, g):
    xf = x.astype(jnp.float32)
    y = xf * lax.rsqrt(jnp.mean(xf * xf, axis=-1, keepdims=True) + EPS)
    return (y * g.astype(jnp.float32)).astype(x.dtype)


def l2norm(x):
    return x * lax.rsqrt(jnp.sum(x * x, axis=-1, keepdims=True) + EPS)


def pool_mixer(u, w_pool, pool_scale):
    B, S, _ = u.shape
    uf = u.astype(jnp.float32)
    csum = jnp.concatenate([jnp.zeros((B, 1, POOL_WIDTH), jnp.float32),
                            jnp.cumsum(uf, axis=1)], axis=1)
    t = jnp.arange(S)
    outs = []
    for gi, w in enumerate(POOL_WINDOWS):
        sl = slice(gi * POOL_GROUP_DIM, (gi + 1) * POOL_GROUP_DIM)
        c = csum[:, :, sl]
        lagged = jnp.concatenate([jnp.zeros((B, w - 1, POOL_GROUP_DIM), jnp.float32),
                                  c[:, :S - w + 1]], axis=1)
        cnt = jnp.minimum(t + 1, w).astype(jnp.float32)[None, :, None]
        outs.append((c[:, 1:] - lagged) / cnt - uf[:, :, sl])
    pooled = jnp.stack(outs, axis=2)
    mixed = jnp.einsum('bsgc,gcd->bsgd', pooled, w_pool.astype(jnp.float32))
    return (mixed.reshape(B, S, POOL_WIDTH) * pool_scale.astype(jnp.float32)).astype(u.dtype)


def causal_dwconv(x, w):
    K, C = w.shape
    return lax.conv_general_dilated(x, w[:, None, :], window_strides=(1,),
                                    padding=[(K - 1, 0)],
                                    dimension_numbers=('NWC', 'WIO', 'NWC'),
                                    feature_group_count=C)


def gated_delta_rule(q, k, v, g, beta):
    B, S, H, Dk = q.shape
    Dv = v.shape[-1]
    NC = S // CHUNK
    q = q * (Dk ** -0.5)

    def chunks(x):
        return x.reshape(B, NC, CHUNK, H, x.shape[-1]).transpose(0, 3, 1, 2, 4)

    qc, kc, vc = chunks(q), chunks(k), chunks(v)
    gc = jnp.cumsum(g.reshape(B, NC, CHUNK, H).transpose(0, 3, 1, 2), axis=-1)
    bc = beta.reshape(B, NC, CHUNK, H).transpose(0, 3, 1, 2)[..., None]

    tril = jnp.tril(jnp.ones((CHUNK, CHUNK), dtype=bool))
    strict = jnp.tril(jnp.ones((CHUNK, CHUNK), dtype=bool), k=-1)
    diff = gc[..., :, None] - gc[..., None, :]
    decay = jnp.where(tril, jnp.exp(jnp.where(tril, diff, 0.0)), 0.0)

    k_beta = kc * bc
    v_beta = vc * bc
    L = jnp.where(strict, jnp.einsum('bhnid,bhnjd->bhnij', k_beta, kc) * decay, 0.0)
    eye = jnp.eye(CHUNK, dtype=jnp.float32)
    T = lax.linalg.triangular_solve(eye + L, jnp.broadcast_to(eye, L.shape),
                                    left_side=True, lower=True)
    u = jnp.einsum('bhnij,bhnjd->bhnid', T, v_beta)
    w = jnp.einsum('bhnij,bhnjd->bhnid', T, k_beta * jnp.exp(gc)[..., None])
    attn = jnp.where(tril, jnp.einsum('bhnid,bhnjd->bhnij', qc, kc) * decay, 0.0)

    def step(state, inp):
        q_c, k_c, u_c, w_c, g_c, a_c = inp
        v_new = u_c - jnp.einsum('bhcd,bhde->bhce', w_c, state)
        o = (jnp.einsum('bhcd,bhde->bhce', q_c * jnp.exp(g_c)[..., None], state)
             + jnp.einsum('bhij,bhje->bhie', a_c, v_new))
        g_last = g_c[..., -1]
        k_dec = k_c * jnp.exp(g_last[..., None] - g_c)[..., None]
        state = state * jnp.exp(g_last)[..., None, None] + jnp.einsum('bhcd,bhce->bhde', k_dec, v_new)
        return state, o

    xs = (jnp.moveaxis(qc, 2, 0), jnp.moveaxis(kc, 2, 0), jnp.moveaxis(u, 2, 0),
          jnp.moveaxis(w, 2, 0), jnp.moveaxis(gc, 2, 0), jnp.moveaxis(attn, 2, 0))
    state0 = jnp.zeros((B, H, Dk, Dv), jnp.float32)
    _, o = lax.scan(step, state0, xs)
    return o.transpose(1, 0, 3, 2, 4).reshape(B, S, H, Dv)


def deltanet_mixer(q, k, v, z, b, a, conv_w, a_log, dt_bias, o_norm_g):
    B, S, _ = q.shape
    dtype = q.dtype
    qkv = jnp.concatenate([q, k, v], axis=-1).astype(jnp.float32)
    qkv = jax.nn.silu(causal_dwconv(qkv, conv_w.astype(jnp.float32)))
    qf, kf, vf = jnp.split(qkv, 3, axis=-1)
    qf = l2norm(qf.reshape(B, S, DN_HEADS, DN_HEAD_DIM))
    kf = l2norm(kf.reshape(B, S, DN_HEADS, DN_HEAD_DIM))
    vf = vf.reshape(B, S, DN_HEADS, DN_HEAD_DIM)
    beta = jax.nn.sigmoid(b.astype(jnp.float32))
    g = -jnp.exp(a_log.astype(jnp.float32)) * jax.nn.softplus(a.astype(jnp.float32) + dt_bias.astype(jnp.float32))
    o = gated_delta_rule(qf, kf, vf, g, beta)
    o = o * lax.rsqrt(jnp.mean(o * o, axis=-1, keepdims=True) + EPS) * o_norm_g.astype(jnp.float32)
    o = o * jax.nn.silu(z.astype(jnp.float32).reshape(B, S, DN_HEADS, DN_HEAD_DIM))
    return o.reshape(B, S, DN_WIDTH).astype(dtype)


def memory_cross_attention(h, m, w_q, w_k, w_v, w_o):
    B, S, _ = h.shape
    M = m.shape[1]
    q = (h @ w_q).reshape(B, S, XA_HEADS, XA_HEAD_DIM)
    k = (m @ w_k).reshape(B, M, XA_HEADS, XA_HEAD_DIM)
    v = (m @ w_v).reshape(B, M, XA_HEADS, XA_HEAD_DIM)
    s = jnp.einsum('bshd,bmhd->bhsm', q, k).astype(jnp.float32) * (XA_HEAD_DIM ** -0.5)
    p = jax.nn.softmax(s, axis=-1).astype(v.dtype)
    o = jnp.einsum('bhsm,bmhd->bshd', p, v).reshape(B, S, D_MODEL)
    return o @ w_o


def sqrelu_mlp(h, w_up, w_down):
    a = jax.nn.relu(h @ w_up)
    return (a * a) @ w_down


def setup_inputs(seed: int = 0) -> dict:
    key = jax.random.key(seed)
    ks = jax.random.split(key, 24)

    def nrm(k, shape, scale):
        return jax.random.normal(k, shape, jnp.float32) * scale

    def gain(k, shape):
        return 1.0 + 0.05 * jax.random.normal(k, shape, jnp.float32)

    L = DEPTH
    return {
        "x": nrm(ks[0], (BATCH, SEQ, D_MODEL), 1.0),
        "mem": nrm(ks[1], (BATCH, MEM_LEN, D_MODEL), 1.0),
        "norm_mix_g": gain(ks[2], (L, D_MODEL)),
        "w_in": nrm(ks[3], (L, D_MODEL, IN_COLS), D_MODEL ** -0.5),
        "w_pool": nrm(ks[4], (L, POOL_GROUPS, POOL_GROUP_DIM, POOL_GROUP_DIM), POOL_GROUP_DIM ** -0.5),
        "pool_scale": gain(ks[5], (L, POOL_WIDTH)),
        "conv_w": nrm(ks[6], (L, CONV_K, 3 * DN_WIDTH), CONV_K ** -0.5),
        "a_log": jnp.log(jax.random.uniform(ks[7], (L, DN_HEADS), jnp.float32, 1.0, 16.0)),
        "dt_bias": 0.5 + 0.1 * jax.random.normal(ks[8], (L, DN_HEADS), jnp.float32),
        "dn_out_norm_g": gain(ks[9], (L, DN_HEAD_DIM)),
        "w_out": nrm(ks[10], (L, MIX_WIDTH, D_MODEL), MIX_WIDTH ** -0.5),
        "norm_xattn_g": gain(ks[11], (L, D_MODEL)),
        "mem_norm_g": gain(ks[12], (L, D_MODEL)),
        "w_xq": nrm(ks[13], (L, D_MODEL, D_MODEL), D_MODEL ** -0.5),
        "w_xk": nrm(ks[14], (L, D_MODEL, D_MODEL), D_MODEL ** -0.5),
        "w_xv": nrm(ks[15], (L, D_MODEL, D_MODEL), D_MODEL ** -0.5),
        "w_xo": nrm(ks[16], (L, D_MODEL, D_MODEL), D_MODEL ** -0.5),
        "norm_mlp_g": gain(ks[17], (L, D_MODEL)),
        "w_up": nrm(ks[18], (L, D_MODEL, D_FF), D_MODEL ** -0.5),
        "w_down": nrm(ks[19], (L, D_FF, D_MODEL), D_FF ** -0.5),
        "final_norm_g": gain(ks[20], (D_MODEL,)),
    }


def reference(x, mem, norm_mix_g, w_in, w_pool, pool_scale, conv_w, a_log, dt_bias,
              dn_out_norm_g, w_out, norm_xattn_g, mem_norm_g, w_xq, w_xk, w_xv, w_xo,
              norm_mlp_g, w_up, w_down, final_norm_g):
    P, W, H = POOL_WIDTH, DN_WIDTH, DN_HEADS
    h = x
    for l in range(DEPTH):
        hn = rmsnorm(h, norm_mix_g[l])
        proj = hn @ w_in[l]
        u_pool = proj[..., :P]
        q = proj[..., P:P + W]
        k = proj[..., P + W:P + 2 * W]
        v = proj[..., P + 2 * W:P + 3 * W]
        z = proj[..., P + 3 * W:P + 4 * W]
        b = proj[..., P + 4 * W:P + 4 * W + H]
        a = proj[..., P + 4 * W + H:]
        y_pool = pool_mixer(u_pool, w_pool[l], pool_scale[l])
        y_dn = deltanet_mixer(q, k, v, z, b, a, conv_w[l], a_log[l], dt_bias[l], dn_out_norm_g[l])
        h = h + jnp.concatenate([y_pool, y_dn], axis=-1) @ w_out[l]
        m = rmsnorm(mem, mem_norm_g[l])
        h = h + memory_cross_attention(rmsnorm(h, norm_xattn_g[l]), m, w_xq[l], w_xk[l], w_xv[l], w_xo[l])
        h = h + sqrelu_mlp(rmsnorm(h, norm_mlp_g[l]), w_up[l], w_down[l])
    return rmsnorm(h, final_norm_g)
```

```cpp
#include <hip/hip_runtime.h>
#include <cstdio>
#include <cstdint>
#include <utility>

#ifndef PROBE_REP
#define PROBE_REP -1
#endif
#ifndef MK_N_LAUNCHES
#define MK_N_LAUNCHES 1
#endif

namespace pg8 {
#define PG8_LAS __attribute__((address_space(3)))
typedef unsigned short bf16_t;
typedef short bf16x8 __attribute__((ext_vector_type(8)));
typedef float f32x4 __attribute__((ext_vector_type(4)));
typedef unsigned u32x4 __attribute__((ext_vector_type(4)));
typedef unsigned u32x2 __attribute__((ext_vector_type(2)));
constexpr int BM = 256, BK = 64, HALF = 128, HTB = HALF * BK * 2  , STAGE_BYTES = 8 * HTB, NXCD = 8, WGM = 4;

__host__ __device__ __forceinline__ int lds_byte(int r, int c) { const int st = (r >> 4) * 2 + (c >> 5), rr = r & 15, cc = c & 31, ob = rr * 64 + cc * 2; return st * 1024 + (ob ^ (((ob >> 9) & 1) << 5)); }
__host__ __device__ __forceinline__ void stage_rc(int b, int& R, int& C) { const int st = b / 1024, sb = b % 1024, swz = sb ^ (((sb >> 9) & 1) << 5); R = (st >> 1) * 16 + swz / 64; C = (st & 1) * 32 + (swz % 64) / 2; }
__host__ __device__ __forceinline__ int perm32(int rho) { const int n = rho >> 4, i = rho & 15; return 8 * (i >> 2) + 4 * n + (i & 3); }

struct Unit { int pm, pn; long ao, bo; int id; };
struct Gemm { const bf16_t* A; const bf16_t* Bt; int lda, ldb, K; size_t akstep = 0, atstep = 0; };

struct StaticOrder {
    int nM, nN, nwg, G, c;
    __host__ __device__ void init(int M, int N, int G_, int c_) { nM = M / BM; nN = N / BM; nwg = nM * nN; G = G_; c = c_; }
    __host__ __device__ bool next(int i, Unit& u) const {
        const long L = (long)i * G + c; if (L >= nwg) return false;
        int wgid = (int)L; { const int q = nwg / NXCD, r = nwg % NXCD, xcd = wgid % NXCD, off = wgid / NXCD; wgid = (xcd < r ? xcd * (q + 1) : r * (q + 1) + (xcd - r) * q) + off; }
        const int nig = WGM * nN, gid = wgid / nig, fm = gid * WGM, gsz = (nM - fm) < WGM ? (nM - fm) : WGM;
        u.pm = fm + ((wgid % nig) % gsz); u.pn = (wgid % nig) / gsz; u.ao = 0; u.bo = 0; u.id = 0; return true;
    }
    __device__ __forceinline__ void a_ready(const Unit&) const {}
    __device__ __forceinline__ void done(const Unit&) const {}
};
struct OneUnit {
    int pm, pn;
    __device__ __forceinline__ bool next(int i, Unit& u) const { if (i != 0) return false; u.pm = pm; u.pn = pn; u.ao = 0; u.bo = 0; u.id = 0; return true; }
    __device__ __forceinline__ void a_ready(const Unit&) const {}
    __device__ __forceinline__ void done(const Unit&) const {}
};

struct PairUnits {
    Unit u0, u1; int n;
    __device__ __forceinline__ bool next(int i, Unit& u) const { if (i >= n) return false; u = i ? u1 : u0; return true; }
    __device__ __forceinline__ void a_ready(const Unit&) const {}
    __device__ __forceinline__ void done(const Unit&) const {}
};

__device__ __forceinline__ unsigned cvt_pk_bf16(float lo, float hi) { unsigned r; asm volatile("v_cvt_pk_bf16_f32 %0, %1, %2" : "=v"(r) : "v"(lo), "v"(hi)); return r; }

constexpr float RMS_EPS = 1e-6f;
__device__ __forceinline__ float rs_from_ssq(const float* ssq, int row) { return 1.0f / sqrtf(ssq[row] * (1.0f / 1024.0f) + RMS_EPS); }

template <int ACT, bool RS> struct EpiStore {
    static constexpr bool PERM = true, AFTER_DRAIN = false;
    bf16_t* O; int ldc; const float* ssq;
    __device__ __forceinline__ void operator()(const f32x4 (&acc)[2][2][4][2], const Unit& u, int wr, int wc, int fr, int fq) const {
        const int row0 = u.pm * BM + wr * 64 + fr, col0 = u.pn * BM + wc * 32 + 8 * fq;
        float rsv[2][4];
#pragma unroll
        for (int ai = 0; ai < 2; ++ai)
#pragma unroll
            for (int m = 0; m < 4; ++m) rsv[ai][m] = RS ? ssq[row0 + ai * HALF + m * 16] : 0.f;
#pragma unroll
        for (int ai = 0; ai < 2; ++ai)
#pragma unroll
            for (int m = 0; m < 4; ++m) { const int row = row0 + ai * HALF + m * 16;
                bf16_t* rowp = (ACT == 1) ? O + ((size_t)(row >> 8) * (ldc >> 6) + (col0 >> 6)) * 16384 + (size_t)(row & 255) * 64 + (col0 & 63) : O + (size_t)row * ldc + col0;
                float rs = 1.f; if (RS) rs = 1.0f / sqrtf(rsv[ai][m] * (1.0f / 1024.0f) + RMS_EPS);
#pragma unroll
                for (int bj = 0; bj < 2; ++bj) { f32x4 v0 = acc[ai][bj][m][0], v1 = acc[ai][bj][m][1];
                    if (RS) { v0 = v0 * rs; v1 = v1 * rs; }
                    if (ACT == 1) {
#pragma unroll
                        for (int j = 0; j < 4; ++j) { const float a = v0[j] > 0.f ? v0[j] : 0.f, b = v1[j] > 0.f ? v1[j] : 0.f; v0[j] = a * a; v1[j] = b * b; } }
                    u32x4 w; w.x = cvt_pk_bf16(v0[0], v0[1]); w.y = cvt_pk_bf16(v0[2], v0[3]); w.z = cvt_pk_bf16(v1[0], v1[1]); w.w = cvt_pk_bf16(v1[2], v1[3]);
                    *(u32x4*)(rowp + (ACT == 1 ? bj * 2 * 16384 : bj * HALF)) = w; } }
    }
};
template <int MODE> struct EpiResid {
    static constexpr bool PERM = false, AFTER_DRAIN = false;
    const float* basef; bf16_t* hb; float* ssq; float* out; const float* gfin; unsigned* cnt;
    __device__ __forceinline__ void operator()(f32x4 (&acc)[2][2][4][2], const Unit& u, int wr, int wc, int fr, int fq) const {
        const int row0 = u.pm * BM + wr * 64 + fr, col0 = u.pn * BM + wc * 32 + 4 * fq;
#pragma unroll
        for (int ai = 0; ai < 2; ++ai) {
            f32x4 bs[4][2][2];
#pragma unroll
            for (int m = 0; m < 4; ++m)
#pragma unroll
                for (int bj = 0; bj < 2; ++bj)
#pragma unroll
                    for (int n = 0; n < 2; ++n) { const size_t o2 = (size_t)(row0 + ai * HALF + m * 16) * 1024 + col0 + bj * HALF + n * 16;
                        if (MODE == 0) { const u32x2 w = __builtin_nontemporal_load((const u32x2*)((const bf16_t*)basef + o2));
                            bs[m][bj][n] = (f32x4){__builtin_bit_cast(float, w.x << 16), __builtin_bit_cast(float, w.x & 0xffff0000u), __builtin_bit_cast(float, w.y << 16), __builtin_bit_cast(float, w.y & 0xffff0000u)}; }
                        else { const u32x2 w = *(const u32x2*)(hb + o2); bs[m][bj][n] = (f32x4){__builtin_bit_cast(float, w.x << 16), __builtin_bit_cast(float, w.x & 0xffff0000u), __builtin_bit_cast(float, w.y << 16), __builtin_bit_cast(float, w.y & 0xffff0000u)}; } }
#pragma unroll
            for (int m = 0; m < 4; ++m) { const int row = row0 + ai * HALF + m * 16; const size_t off = (size_t)row * 1024 + col0; float ss = 0.f;
#pragma unroll
                for (int bj = 0; bj < 2; ++bj)
#pragma unroll
                    for (int n = 0; n < 2; ++n) { const size_t o2 = off + bj * HALF + n * 16; const f32x4 o = bs[m][bj][n] + acc[ai][bj][m][n];
                        ss += (o[0] * o[0] + o[1] * o[1]) + (o[2] * o[2] + o[3] * o[3]);
                        if (MODE == 2) acc[ai][bj][m][n] = o;
                        else { u32x2 w; w.x = cvt_pk_bf16(o[0], o[1]); w.y = cvt_pk_bf16(o[2], o[3]); *(u32x2*)(hb + o2) = w; } }
                ss += __shfl_xor(ss, 16); ss += __shfl_xor(ss, 32); if (fq == 0) atomicAdd(ssq + row, ss); }
            asm volatile("" ::: "memory"); }
        if (MODE == 2) {
            asm volatile("s_waitcnt vmcnt(0)" ::: "memory");
            unsigned* c = cnt + 64 * u.pm;
            if (fr == 0 && fq == 0) __hip_atomic_fetch_add(c, 1u, __ATOMIC_RELAXED, __HIP_MEMORY_SCOPE_AGENT);
            unsigned spins = 0;
            while (__hip_atomic_load(c, __ATOMIC_RELAXED, __HIP_MEMORY_SCOPE_AGENT) < 32u) { __builtin_amdgcn_s_sleep(2); if (++spins > (1u << 22)) break; }
            asm volatile("" ::: "memory");
            f32x4 gv[2][2];
#pragma unroll
            for (int bj = 0; bj < 2; ++bj)
#pragma unroll
                for (int n = 0; n < 2; ++n) gv[bj][n] = *(const f32x4*)(gfin + col0 + bj * HALF + n * 16);
            float sv[2][4];
#pragma unroll
            for (int ai = 0; ai < 2; ++ai)
#pragma unroll
                for (int m = 0; m < 4; ++m) sv[ai][m] = __hip_atomic_load(ssq + row0 + ai * HALF + m * 16, __ATOMIC_RELAXED, __HIP_MEMORY_SCOPE_AGENT);
#pragma unroll
            for (int ai = 0; ai < 2; ++ai)
#pragma unroll
                for (int m = 0; m < 4; ++m) { const float rs = 1.0f / sqrtf(sv[ai][m] * (1.0f / 1024.0f) + RMS_EPS); const size_t off = (size_t)(row0 + ai * HALF + m * 16) * 1024 + col0;
#pragma unroll
                    for (int bj = 0; bj < 2; ++bj)
#pragma unroll
                        for (int n = 0; n < 2; ++n) *(f32x4*)(out + off + bj * HALF + n * 16) = acc[ai][bj][m][n] * rs * gv[bj][n]; }
        }
    }
};
struct EpiSoftmax {
    static constexpr bool PERM = true, AFTER_DRAIN = true;
    bf16_t* P; float scale_log2e;
    __device__ __forceinline__ void fused(f32x4 (&acc)[2][2][4][2], const Unit& u, int wr, int wc, int fr, int fq, PG8_LAS unsigned char* lds, int wid, int lane) const {
        PG8_LAS float* RM = (PG8_LAS float*)lds;
        PG8_LAS float* RSM = (PG8_LAS float*)(lds + 4096);
#pragma unroll
        for (int ai = 0; ai < 2; ++ai)
#pragma unroll
            for (int m = 0; m < 4; ++m) { float mx = -3.0e38f;
#pragma unroll
                for (int bj = 0; bj < 2; ++bj)
#pragma unroll
                    for (int n = 0; n < 2; ++n) { const f32x4 x = acc[ai][bj][m][n]; mx = fmaxf(mx, fmaxf(fmaxf(x[0], x[1]), fmaxf(x[2], x[3]))); }
                mx = fmaxf(mx, __shfl_xor(mx, 16)); mx = fmaxf(mx, __shfl_xor(mx, 32));
                if (fq == 0) RM[(ai * HALF + wr * 64 + m * 16 + fr) * 4 + wc] = mx; }
        asm volatile("s_waitcnt lgkmcnt(0)" ::: "memory"); __builtin_amdgcn_s_barrier(); asm volatile("" ::: "memory");
#pragma unroll
        for (int ai = 0; ai < 2; ++ai)
#pragma unroll
            for (int m = 0; m < 4; ++m) { const int r = ai * HALF + wr * 64 + m * 16 + fr; const f32x4 m4 = *(const PG8_LAS f32x4*)(RM + r * 4);
                const float gm = fmaxf(fmaxf(m4[0], m4[1]), fmaxf(m4[2], m4[3])); float s = 0.f;
#pragma unroll
                for (int bj = 0; bj < 2; ++bj)
#pragma unroll
                    for (int n = 0; n < 2; ++n) { f32x4 x = acc[ai][bj][m][n];
#pragma unroll
                        for (int j = 0; j < 4; ++j) { x[j] = __builtin_amdgcn_exp2f((x[j] - gm) * scale_log2e); s += x[j]; }
                        acc[ai][bj][m][n] = x; }
                s += __shfl_xor(s, 16); s += __shfl_xor(s, 32);
                if (fq == 0) RSM[r * 4 + wc] = s; }
        asm volatile("s_waitcnt lgkmcnt(0)" ::: "memory"); __builtin_amdgcn_s_barrier(); asm volatile("" ::: "memory");
        const int col0 = wc * 32 + 8 * fq;
#pragma unroll
        for (int ai = 0; ai < 2; ++ai)
#pragma unroll
            for (int m = 0; m < 4; ++m) { const int r = ai * HALF + wr * 64 + m * 16 + fr; const f32x4 s4 = *(const PG8_LAS f32x4*)(RSM + r * 4);
                const float inv = 1.0f / ((s4[0] + s4[1]) + (s4[2] + s4[3])); bf16_t* rowp = P + (size_t)r * 256 + col0;
#pragma unroll
                for (int bj = 0; bj < 2; ++bj) { const f32x4 v0 = acc[ai][bj][m][0] * inv, v1 = acc[ai][bj][m][1] * inv;
                    u32x4 w; w.x = cvt_pk_bf16(v0[0], v0[1]); w.y = cvt_pk_bf16(v0[2], v0[3]); w.z = cvt_pk_bf16(v1[0], v1[1]); w.w = cvt_pk_bf16(v1[2], v1[3]);
                    *(u32x4*)(rowp + bj * HALF) = w; } }
    }
};

struct EpiSoftmaxS {
    static constexpr bool PERM = true, AFTER_DRAIN = false;
    bf16_t* P; float scale_log2e; PG8_LAS unsigned char* tab;
    __device__ __forceinline__ void operator()(f32x4 (&acc)[2][2][4][2], const Unit& u, int wr, int wc, int fr, int fq) const {
        EpiSoftmax E{P + (size_t)u.id * 65536, scale_log2e};
        E.fused(acc, u, wr, wc, fr, fq, tab, 0, 0);
    }
};

template <class Epi, class Sched, bool ALIGN_EPI = false, bool SP2 = false>
__device__ __forceinline__ void gemm_phase(PG8_LAS unsigned char* lds, const Gemm g, const Sched& S, const Epi& E) {
    int tid_ = threadIdx.x; asm volatile("" : "+v"(tid_));
    const int tid = tid_, wid = __builtin_amdgcn_readfirstlane(tid >> 6), lane = tid & 63, wr = wid >> 2, wc = wid & 3, fr = lane & 15, fq = lane >> 4;
    const int K = g.K, nt = K / BK;
    unsigned voffA[2], voffB[2];
#pragma unroll
    for (int i = 0; i < 2; ++i) { int R, C; stage_rc(tid * 16 + i * 8192, R, C); const int Rb = Epi::PERM ? ((R & ~31) + perm32(R & 31)) : R;
        voffA[i] = (unsigned)(R * g.lda + C) * 2u; voffB[i] = (unsigned)(Rb * g.ldb + C) * 2u; }
    const size_t kstep = (size_t)(BK * 2);
    const size_t hstepA = (size_t)HALF * g.lda * 2, hstepB = (size_t)HALF * g.ldb * 2;
    const size_t tstepA = g.atstep ? g.atstep : 2 * hstepA, tstepB = 2 * hstepB;
    const size_t kstepA = g.akstep ? g.akstep : kstep;
    const unsigned ldsw = (unsigned)wid * 1024u;
    const int aoff = lds_byte(wr * 64 + fr, fq * 8), boff = lds_byte(wc * 32 + fr, fq * 8);
#define PG8_SA(b, h) (((b) * 2 + (h)) * HTB)
#define PG8_SB(b, h) ((4 + (b) * 2 + (h)) * HTB)
#define PG8_STAGE(bufoff, gbase, voff) do { _Pragma("unroll") for (int _i = 0; _i < 2; ++_i) \
        __builtin_amdgcn_global_load_lds((const unsigned*)((const char*)(gbase) + (voff)[_i]), (PG8_LAS unsigned*)(lds + (bufoff) + ldsw + _i * 8192), 16, 0, 0); } while (0)
#define PG8_LDA(dst, b, h) do { _Pragma("unroll") for (int m = 0; m < 4; ++m) _Pragma("unroll") for (int k = 0; k < 2; ++k) dst[m][k] = *(const PG8_LAS bf16x8*)(lds + PG8_SA(b, h) + aoff + m * 2048 + k * 1024); } while (0)
#define PG8_LDB(dst, b, h) do { _Pragma("unroll") for (int n = 0; n < 2; ++n) _Pragma("unroll") for (int k = 0; k < 2; ++k) dst[n][k] = *(const PG8_LAS bf16x8*)(lds + PG8_SB(b, h) + boff + n * 2048 + k * 1024); } while (0)
#define PG8_MMA(ai, bj, At, Bt) do { __builtin_amdgcn_s_setprio(1); _Pragma("unroll") for (int m = 0; m < 4; ++m) _Pragma("unroll") for (int n = 0; n < 2; ++n) _Pragma("unroll") for (int k = 0; k < 2; ++k) \
        acc[ai][bj][m][n] = __builtin_amdgcn_mfma_f32_16x16x32_bf16(Bt[n][k], At[m][k], acc[ai][bj][m][n], 0, 0, 0); __builtin_amdgcn_s_setprio(0); } while (0)
#define PG8_WAIT_V(n) asm volatile("s_waitcnt vmcnt(" #n ")" ::: "memory")
#define PG8_WAIT_L(n) asm volatile("s_waitcnt lgkmcnt(" #n ")" ::: "memory")
#define PG8_BAR __builtin_amdgcn_s_barrier()
#define PG8_SCHED __builtin_amdgcn_sched_barrier(0)
    Unit cur, nxt; int ui = 0;
    if (!S.next(0, cur)) return;
    f32x4 acc[2][2][4][2];
#pragma unroll
    for (int a = 0; a < 2; ++a)
#pragma unroll
        for (int b = 0; b < 2; ++b)
#pragma unroll
            for (int m = 0; m < 4; ++m)
#pragma unroll
                for (int n = 0; n < 2; ++n) acc[a][b][m][n] = (f32x4){0.f, 0.f, 0.f, 0.f};
    bf16x8 At[4][2], B0[2][2], B1[2][2];
    const char* cA = (const char*)g.A + (size_t)cur.pm * tstepA + cur.ao; const char* cB = (const char*)g.Bt + (size_t)cur.pn * tstepB + cur.bo;
    S.a_ready(cur);
    if constexpr (SP2) {
        PG8_STAGE(PG8_SB(0, 0), cB, voffB); PG8_STAGE(PG8_SB(0, 1), cB + hstepB, voffB); PG8_STAGE(PG8_SA(0, 0), cA, voffA); PG8_STAGE(PG8_SA(0, 1), cA + hstepA, voffA);
        if (wr == 1) PG8_BAR;
        PG8_WAIT_V(2); PG8_BAR;
        PG8_STAGE(PG8_SB(1, 0), cB + kstep, voffB); PG8_STAGE(PG8_SA(1, 0), cA + kstepA, voffA); PG8_STAGE(PG8_SB(1, 1), cB + hstepB + kstep, voffB);
        PG8_WAIT_V(6); PG8_BAR;
    } else {
        PG8_STAGE(PG8_SB(0, 0), cB, voffB); PG8_STAGE(PG8_SA(0, 0), cA, voffA); PG8_STAGE(PG8_SB(0, 1), cB + hstepB, voffB); PG8_STAGE(PG8_SA(0, 1), cA + hstepA, voffA);
        if (wr == 1) PG8_BAR;
        PG8_WAIT_V(4); PG8_BAR;
        PG8_STAGE(PG8_SB(1, 0), cB + kstep, voffB); PG8_STAGE(PG8_SA(1, 0), cA + kstepA, voffA); PG8_STAGE(PG8_SB(1, 1), cB + hstepB + kstep, voffB);
        PG8_WAIT_V(6); PG8_BAR;
    }
    for (;;) {
        const bool has_next = S.next(ui + 1, nxt);
        const char* nA = has_next ? (const char*)g.A + (size_t)nxt.pm * tstepA + nxt.ao : cA; const char* nB = has_next ? (const char*)g.Bt + (size_t)nxt.pn * tstepB + nxt.bo : cB;
#pragma unroll 1
        for (int t = 0; t < nt; t += 2) {
            const bool last = (t == nt - 2);
            const char* a1 = cA + (size_t)(t + 1) * kstepA;
            const char* a2 = last ? nA : cA + (size_t)(t + 2) * kstepA; const char* b2 = last ? nB : cB + (size_t)(t + 2) * kstep;
            const char* a3 = a2 + kstepA; const char* b3 = b2 + kstep;
            if (last && has_next) S.a_ready(nxt);
            if constexpr (SP2) {
            PG8_LDB(B0, 0, 0); PG8_LDB(B1, 0, 1); PG8_SCHED; PG8_LDA(At, 0, 0); PG8_STAGE(PG8_SA(1, 1), a1 + hstepA, voffA);
            PG8_WAIT_V(8); PG8_WAIT_L(0); PG8_BAR; PG8_MMA(0, 0, At, B0); PG8_MMA(0, 1, At, B1); PG8_BAR; PG8_SCHED;
            PG8_LDA(At, 0, 1); PG8_STAGE(PG8_SB(0, 0), b2, voffB); PG8_STAGE(PG8_SB(0, 1), b2 + hstepB, voffB); PG8_STAGE(PG8_SA(0, 0), a2, voffA);
            PG8_WAIT_V(8); PG8_WAIT_L(0); PG8_BAR; PG8_MMA(1, 0, At, B0); PG8_MMA(1, 1, At, B1); PG8_BAR; PG8_SCHED;
            PG8_LDB(B0, 1, 0); PG8_LDB(B1, 1, 1); PG8_SCHED; PG8_LDA(At, 1, 0); PG8_STAGE(PG8_SA(0, 1), a2 + hstepA, voffA);
            PG8_WAIT_V(8); PG8_WAIT_L(0); PG8_BAR; PG8_MMA(0, 0, At, B0); PG8_MMA(0, 1, At, B1); PG8_BAR; PG8_SCHED;
            PG8_LDA(At, 1, 1); PG8_STAGE(PG8_SB(1, 0), b3, voffB); PG8_STAGE(PG8_SB(1, 1), b3 + hstepB, voffB); PG8_STAGE(PG8_SA(1, 0), a3, voffA);
            PG8_WAIT_V(8); PG8_WAIT_L(0); PG8_BAR; PG8_MMA(1, 0, At, B0); PG8_MMA(1, 1, At, B1); PG8_BAR; PG8_SCHED;
            } else {
            PG8_LDB(B0, 0, 0); PG8_SCHED; PG8_LDA(At, 0, 0); PG8_STAGE(PG8_SA(1, 1), a1 + hstepA, voffA);
            PG8_WAIT_L(8); PG8_BAR; PG8_WAIT_L(0); PG8_MMA(0, 0, At, B0); PG8_BAR; PG8_SCHED;
            PG8_LDB(B1, 0, 1); PG8_STAGE(PG8_SB(0, 0), b2, voffB);
            PG8_BAR; PG8_WAIT_L(0); PG8_MMA(0, 1, At, B1); PG8_BAR;
            PG8_LDA(At, 0, 1); PG8_STAGE(PG8_SA(0, 0), a2, voffA);
            PG8_BAR; PG8_WAIT_L(0); PG8_MMA(1, 0, At, B0); PG8_BAR; PG8_SCHED;
            PG8_STAGE(PG8_SB(0, 1), b2 + hstepB, voffB);
            PG8_WAIT_V(6); PG8_BAR; PG8_MMA(1, 1, At, B1); PG8_BAR;
            PG8_LDB(B0, 1, 0); PG8_SCHED; PG8_LDA(At, 1, 0); PG8_STAGE(PG8_SA(0, 1), a2 + hstepA, voffA);
            PG8_WAIT_L(8); PG8_BAR; PG8_WAIT_L(0); PG8_MMA(0, 0, At, B0); PG8_BAR; PG8_SCHED;
            PG8_LDB(B1, 1, 1); PG8_STAGE(PG8_SB(1, 0), b3, voffB);
            PG8_BAR; PG8_WAIT_L(0); PG8_MMA(0, 1, At, B1); PG8_BAR;
            PG8_LDA(At, 1, 1); PG8_STAGE(PG8_SA(1, 0), a3, voffA);
            PG8_BAR; PG8_WAIT_L(0); PG8_MMA(1, 0, At, B0); PG8_BAR; PG8_SCHED;
            PG8_STAGE(PG8_SB(1, 1), b3 + hstepB, voffB);
            PG8_WAIT_V(6); PG8_BAR; PG8_MMA(1, 1, At, B1); PG8_BAR;
            }
        }
        if constexpr (ALIGN_EPI) { if (wr == 0) PG8_BAR; }
        if constexpr (!Epi::AFTER_DRAIN) { E(acc, cur, wr, wc, fr, fq); S.done(cur); }
        if (!has_next) break;
#pragma unroll
        for (int a = 0; a < 2; ++a)
#pragma unroll
            for (int b = 0; b < 2; ++b)
#pragma unroll
                for (int m = 0; m < 4; ++m)
#pragma unroll
                    for (int n = 0; n < 2; ++n) acc[a][b][m][n] = (f32x4){0.f, 0.f, 0.f, 0.f};
        cur = nxt; cA = nA; cB = nB; ++ui;
        if constexpr (ALIGN_EPI) { if (wr == 1) PG8_BAR; }
    }
    PG8_WAIT_V(0);
    if constexpr (!ALIGN_EPI) { if (wr == 0) PG8_BAR; }
    PG8_BAR;
    if constexpr (Epi::AFTER_DRAIN) { E.fused(acc, cur, wr, wc, fr, fq, lds, wid, lane); S.done(cur); }
#undef PG8_SA
#undef PG8_SB
#undef PG8_STAGE
#undef PG8_LDA
#undef PG8_LDB
#undef PG8_MMA
#undef PG8_WAIT_V
#undef PG8_WAIT_L
#undef PG8_BAR
#undef PG8_SCHED
}
}

constexpr int NWAVES = 8;
constexpr int N_LAUNCHES = MK_N_LAUNCHES;
constexpr int N_PHASES = 11;
constexpr int BATCH = 16, SEQ = 2048, D = 1024, M = BATCH * SEQ;
constexpr int NPROJ = 2560, INCOLS = 2568, MEML = 256, MROWS = BATCH * MEML, FF = 4096;
constexpr int DNW = 512, DNH = 4, DNHD = 128, CHUNK = 64;

constexpr size_t MiB = 1u << 20;
constexpr size_t WS_CTL = 0, CTL_ZERO_BYTES = 1 * MiB;
constexpr size_t WS_BA = 1 * MiB;
constexpr size_t WS_SSQ1 = 256 * 1024, WS_SSQ2 = 512 * 1024, WS_SSQ3 = 768 * 1024, WS_CNT3 = 896 * 1024;
constexpr size_t WS_WIN = 8 * MiB, WS_WOUT = 13 * MiB, WS_WQ = 15 * MiB, WS_WK = 17 * MiB, WS_WV = 19 * MiB, WS_WO = 21 * MiB, WS_WUP = 23 * MiB, WS_WDN = 31 * MiB;
constexpr size_t WS_MN = 40 * MiB, WS_KM = 48 * MiB, WS_VT = 56 * MiB;
constexpr size_t WS_A = 64 * MiB;
constexpr size_t WS_SSQ0 = 2 * MiB;
constexpr size_t WS_Y = 352 * MiB;
constexpr size_t WS_B = 128 * MiB;
constexpr size_t WS_C = 192 * MiB;
constexpr size_t WS_PS = 256 * MiB;
constexpr size_t WS_OR = 128 * MiB;
constexpr size_t WS_GWM = 352 * MiB, WS_GUT = 384 * MiB, WS_GQG = 416 * MiB, WS_GKD = 448 * MiB, WS_GAM = 480 * MiB, WS_GGL = 496 * MiB;
constexpr size_t WS_END = 497 * MiB;
constexpr int CW_BAR = 4096;

constexpr int RING_BYTES = 131072;
constexpr int LDS_BYTES = 147456;
constexpr int LDSCTL_OFF = LDS_BYTES - 512, MISC_OFF = LDSCTL_OFF + 320;

#define GAS __attribute__((address_space(1)))
#define LAS __attribute__((address_space(3)))
typedef unsigned short bf16;
typedef unsigned v4u __attribute__((ext_vector_type(4)));
typedef unsigned v2u __attribute__((ext_vector_type(2)));
typedef float f32x4 __attribute__((ext_vector_type(4)));
typedef GAS unsigned gu32;
#define LDS_WAIT() asm volatile("s_waitcnt lgkmcnt(0)" ::: "memory")
#define VM_WAIT() asm volatile("s_waitcnt vmcnt(0)" ::: "memory")
typedef float f32x2_t __attribute__((ext_vector_type(2)));
typedef __bf16 bf16x2_t __attribute__((ext_vector_type(2)));
__device__ __forceinline__ unsigned pk2(float lo, float hi) { const f32x2_t v = {lo, hi}; const bf16x2_t b = __builtin_convertvector(v, bf16x2_t); return __builtin_bit_cast(unsigned, b); }
__device__ __forceinline__ unsigned f2bf(float f) { return pk2(f, 0.f) & 0xffffu; }
__device__ __forceinline__ float bflo(unsigned w) { return __builtin_bit_cast(float, w << 16); }
__device__ __forceinline__ float bfhi(unsigned w) { return __builtin_bit_cast(float, w & 0xffff0000u); }
__device__ __forceinline__ void unpack8(const v4u w, float (&f)[8]) { f[0] = bflo(w.x); f[1] = bfhi(w.x); f[2] = bflo(w.y); f[3] = bfhi(w.y); f[4] = bflo(w.z); f[5] = bfhi(w.z); f[6] = bflo(w.w); f[7] = bfhi(w.w); }

#define XB_TMO      128
#define XB_XCNT(j)  (256  + 64 * (j))
#define XB_XSUB(j)  (1280 + 64 * (j))
#define XB_XGEN(j)  (2304 + 64 * (j))
#define XB_TOP      3328
#define XB_TOPGEN   3392
#define XCD_BAR_WORDS 3456
#define XB_SPIN_CAP (1u << 18)
__device__ __forceinline__ unsigned xb_ld(unsigned* p)              { return __hip_atomic_load(p, __ATOMIC_RELAXED, __HIP_MEMORY_SCOPE_AGENT); }
__device__ __forceinline__ unsigned xb_add(unsigned* p, unsigned v) { return __hip_atomic_fetch_add(p, v, __ATOMIC_RELAXED, __HIP_MEMORY_SCOPE_AGENT); }
__device__ __forceinline__ unsigned xb_xcc_id() { return (unsigned)__builtin_amdgcn_s_getreg((3 << 11) | 20) & 0xFu; }
#define XB_SPIN(cond, bar) do { unsigned _sp = 0; while (cond) { __builtin_amdgcn_s_sleep(1); \
    if ((++_sp & 255u) == 0u) { if (xb_ld(&(bar)[XB_TMO])) break; if (_sp > XB_SPIN_CAP) { atomicAdd(&(bar)[XB_TMO], 1u); break; } } } } while (0)
struct XcdBarrier { unsigned* bar; unsigned x; volatile LAS unsigned* st; };
__device__ __forceinline__ XcdBarrier xcd_barrier_post(unsigned* bar, volatile LAS unsigned* st) {
    XcdBarrier b; b.bar = bar; b.x = xb_xcc_id(); b.st = st;
    if (threadIdx.x == 0) (void)xb_add(&bar[XB_XCNT(b.x)], 1u);
    return b;
}
__device__ __forceinline__ void xcd_barrier_complete(unsigned* bar, unsigned x, unsigned& nloc, unsigned& nx) {
    const unsigned G = gridDim.x * gridDim.y * gridDim.z;
    unsigned sum, cnt, mine, sp = 0u;
    for (;;) {
        sum = 0u; cnt = 0u; mine = 0u;
#pragma unroll
        for (unsigned j = 0; j < 16; ++j) { const unsigned c = xb_ld(&bar[XB_XCNT(j)]); sum += c; cnt += (c > 0u) ? 1u : 0u; mine = (j == x) ? c : mine; }
        if (sum == G) break;
        __builtin_amdgcn_s_sleep(1);
        if ((++sp & 255u) == 0u) { if (xb_ld(&bar[XB_TMO])) break; if (sp > XB_SPIN_CAP) { atomicAdd(&bar[XB_TMO], 1u); break; } }
    }
    nloc = mine > 0u ? mine : 1u; nx = cnt > 0u ? cnt : 1u;
}
__device__ __forceinline__ void xcd_barrier(const XcdBarrier& b) {
    asm volatile("s_waitcnt vmcnt(0)" ::: "memory");
    __syncthreads();
    if (threadIdx.x == 0) {
        unsigned* bar = b.bar;
        __builtin_amdgcn_s_waitcnt(0);
        unsigned nloc = b.st[0], nx = b.st[1];
        if (nloc == 0u) { xcd_barrier_complete(bar, b.x, nloc, nx); b.st[0] = nloc; b.st[1] = nx; }
        const unsigned old = xb_add(&bar[XB_XSUB(b.x)], 1u);
        const unsigned gen = old / nloc;
        if (old + 1u == (gen + 1u) * nloc) {
            __builtin_amdgcn_fence(__ATOMIC_RELEASE, "agent");
            asm volatile("s_waitcnt vmcnt(0)" ::: "memory");
            const unsigned og = xb_add(&bar[XB_TOP], 1u);
            const unsigned tg = og / nx;
            if (og + 1u == (tg + 1u) * nx) xb_add(&bar[XB_TOPGEN], 1u);
            else XB_SPIN(xb_ld(&bar[XB_TOPGEN]) == tg, bar);
            __builtin_amdgcn_fence(__ATOMIC_ACQUIRE, "agent");
            xb_add(&bar[XB_XGEN(b.x)], 1u);
            asm volatile("s_waitcnt vmcnt(0)" ::: "memory");
        } else {
            XB_SPIN(xb_ld(&bar[XB_XGEN(b.x)]) == gen, bar);
            __builtin_amdgcn_fence(__ATOMIC_ACQUIRE, "agent");
            asm volatile("s_waitcnt vmcnt(0)" ::: "memory");
        }
    }
    __syncthreads();
}


__device__ __forceinline__ float dppf(float v, const int ctrl_sel) {
    const int x = __builtin_bit_cast(int, v); int r;
    if (ctrl_sel == 0) r = __builtin_amdgcn_update_dpp(0, x, 0xB1, 0xF, 0xF, true);
    else if (ctrl_sel == 1) r = __builtin_amdgcn_update_dpp(0, x, 0x4E, 0xF, 0xF, true);
    else if (ctrl_sel == 2) r = __builtin_amdgcn_update_dpp(0, x, 0x141, 0xF, 0xF, true);
    else r = __builtin_amdgcn_update_dpp(0, x, 0x140, 0xF, 0xF, true);
    return __builtin_bit_cast(float, r);
}
__device__ __forceinline__ float row16_sum(float v) {
    v += dppf(v, 0); v += dppf(v, 1); v += dppf(v, 2); v += dppf(v, 3); return v;
}
__device__ __forceinline__ float wave_sum(float v) {
    v = row16_sum(v);
    const int x = __builtin_bit_cast(int, v);
    const float a = __builtin_bit_cast(float, __builtin_amdgcn_readlane(x, 0)), b = __builtin_bit_cast(float, __builtin_amdgcn_readlane(x, 16));
    const float c = __builtin_bit_cast(float, __builtin_amdgcn_readlane(x, 32)), d = __builtin_bit_cast(float, __builtin_amdgcn_readlane(x, 48));
    return (a + b) + (c + d);
}
__device__ __forceinline__ float silu_f(float x) { return x * __builtin_amdgcn_rcpf(1.0f + __expf(-x)); }

#define PHASE_TID() int tid_ = threadIdx.x; asm volatile("" : "+v"(tid_)); const int tid = tid_, lane = tid & 63, wave = __builtin_amdgcn_readfirstlane(tid >> 6); (void)lane; (void)wave
struct Ctx {
    LAS unsigned char* lds;
    int vcu, G;
    const float *x, *mem, *g_mix, *w_in, *w_pool, *pool_scale, *conv_w, *a_log, *dt_bias, *g_dn, *w_out, *g_xa, *g_mem, *w_xq, *w_xk, *w_xv, *w_xo, *g_mlp, *w_up, *w_down, *g_fin;
    float* out; unsigned char* ws;
};

__device__ __forceinline__ void transpose_item(const float* W, int ldw, int nblk, const float* kscale, bf16* WT, int ldt, int koff, LAS float* scr, int item, int lane) {
    const int kb = item / nblk, nb = item % nblk, k0 = 64 * kb, n0 = 32 * nb;
    f32x4 wv[8];
#pragma unroll
    for (int i = 0; i < 8; ++i) wv[i] = __builtin_nontemporal_load((const f32x4*)(W + (size_t)(k0 + (lane >> 3) + 8 * i) * ldw + n0 + 4 * (lane & 7)));
#pragma unroll
    for (int i = 0; i < 8; ++i) { const int kk = (lane >> 3) + 8 * i; f32x4 v = wv[i]; if (kscale) v = v * kscale[k0 + kk];
        LAS float* d = scr + kk * 33 + 4 * (lane & 7); d[0] = v[0]; d[1] = v[1]; d[2] = v[2]; d[3] = v[3]; }
    LDS_WAIT(); asm volatile("" ::: "memory");
    const int c = lane & 7;
#pragma unroll
    for (int j = 0; j < 4; ++j) { const int n = (lane >> 3) + 8 * j; const LAS float* s = scr + (8 * c) * 33 + n;
        v4u o; o.x = pk2(s[0 * 33], s[1 * 33]); o.y = pk2(s[2 * 33], s[3 * 33]); o.z = pk2(s[4 * 33], s[5 * 33]); o.w = pk2(s[6 * 33], s[7 * 33]);
        *(GAS v4u*)(WT + (size_t)(n0 + n) * ldt + koff + k0 + 8 * c) = o; }
    LDS_WAIT(); asm volatile("" ::: "memory");
}

__device__ __forceinline__ void late_weight_copies(const Ctx& F, int wgi, int nwg) {
    PHASE_TID();
    LAS float* scr = (LAS float*)(F.lds + wave * 16384);
    bf16* WQ = (bf16*)(F.ws + WS_WQ); bf16* WO = (bf16*)(F.ws + WS_WO); bf16* WUP = (bf16*)(F.ws + WS_WUP); bf16* WDN = (bf16*)(F.ws + WS_WDN);
    constexpr int I_SQ = 16 * 32, I_UP = 16 * 128, I_DN = 64 * 32, NITEMS = 2 * I_SQ + I_UP + I_DN;
    for (int it = wgi * NWAVES + wave; it < NITEMS; it += nwg * NWAVES) {
        int r = it;
        if (r < I_SQ) { transpose_item(F.w_xq, 1024, 32, F.g_xa, WQ, 1024, 0, scr, r, lane); continue; } r -= I_SQ;
        if (r < I_SQ) { transpose_item(F.w_xo, 1024, 32, nullptr, WO, 1024, 0, scr, r, lane); continue; } r -= I_SQ;
        if (r < I_UP) { transpose_item(F.w_up, 4096, 128, F.g_mlp, WUP, 1024, 0, scr, r, lane); continue; } r -= I_UP;
        transpose_item(F.w_down, 1024, 32, nullptr, WDN, 4096, 0, scr, r, lane);
    }
}

__device__ __forceinline__ void p0_prologue(const Ctx& F) {
    PHASE_TID();
    LAS float* scr = (LAS float*)(F.lds + wave * 16384);
    const int gw = F.vcu * NWAVES + wave, NGW = F.G * NWAVES;
    bf16* WIN = (bf16*)(F.ws + WS_WIN); bf16* WOUT = (bf16*)(F.ws + WS_WOUT); bf16* WK = (bf16*)(F.ws + WS_WK);
    bf16* WV = (bf16*)(F.ws + WS_WV);
    constexpr int I_IN = 16 * 80, I_OUT = 8 * 32, I_SQ = 16 * 32;
    constexpr int NITEMS = I_IN + I_OUT + 2 * I_SQ;
    for (int it = gw; it < NITEMS; it += NGW) {
        int r = it;
        if (r < I_IN) { transpose_item(F.w_in, INCOLS, 80, F.g_mix, WIN, 1024, 0, scr, r, lane); continue; } r -= I_IN;
        if (r < I_OUT) { transpose_item(F.w_out + (size_t)512 * 1024, 1024, 32, nullptr, WOUT, 1024, 512, scr, r, lane); continue; } r -= I_OUT;
        if (r < I_SQ) { transpose_item(F.w_xk, 1024, 32, nullptr, WK, 1024, 0, scr, r, lane); continue; } r -= I_SQ;
        transpose_item(F.w_xv, 1024, 32, nullptr, WV, 1024, 0, scr, r, lane);
    }
    for (int it = (F.vcu * NWAVES * 64) + tid; it < 1024 * 64; it += F.G * NWAVES * 64) {
        const int n = it & 1023, k8 = it >> 10, g = k8 >> 4, c0 = (k8 & 15) * 8;
        float acc[8];
#pragma unroll
        for (int j = 0; j < 8; ++j) acc[j] = 0.f;
        const float* wp = F.w_pool + (size_t)(g * 128 + c0) * 128;
        for (int d = 0; d < 128; ++d) { const float wo = F.w_out[(size_t)(g * 128 + d) * 1024 + n] * F.pool_scale[g * 128 + d];
#pragma unroll
            for (int j = 0; j < 8; ++j) acc[j] += wp[j * 128 + d] * wo; }
        v4u o; o.x = pk2(acc[0], acc[1]); o.y = pk2(acc[2], acc[3]); o.z = pk2(acc[4], acc[5]); o.w = pk2(acc[6], acc[7]);
        *(GAS v4u*)(WOUT + (size_t)n * 1024 + g * 128 + c0) = o;
    }
    {
        float wba[16][8];
#pragma unroll
        for (int j = 0; j < 4; ++j)
#pragma unroll
            for (int i = 0; i < 4; ++i) { const int k = 4 * lane + 256 * j + i; const f32x4* p = (const f32x4*)(F.w_in + (size_t)k * INCOLS + NPROJ); const f32x4 a = p[0], b = p[1];
                wba[j * 4 + i][0] = a[0]; wba[j * 4 + i][1] = a[1]; wba[j * 4 + i][2] = a[2]; wba[j * 4 + i][3] = a[3]; wba[j * 4 + i][4] = b[0]; wba[j * 4 + i][5] = b[1]; wba[j * 4 + i][6] = b[2]; wba[j * 4 + i][7] = b[3]; }
        f32x4 gv[4];
#pragma unroll
        for (int j = 0; j < 4; ++j) gv[j] = ((const f32x4*)F.g_mix)[lane + 64 * j];
        bf16* XN = (bf16*)(F.ws + WS_A); float* BA = (float*)(F.ws + WS_BA);
        for (int m = gw; m < M; m += NGW) {
            const GAS f32x4* xr = (const GAS f32x4*)(F.x + (size_t)m * D) + lane;
            f32x4 v[4]; float s = 0.f;
#pragma unroll
            for (int j = 0; j < 4; ++j) { v[j] = __builtin_nontemporal_load(xr + 64 * j); s += (v[j][0] * v[j][0] + v[j][1] * v[j][1]) + (v[j][2] * v[j][2] + v[j][3] * v[j][3]); }
            const float ssx = wave_sum(s);
            const float rs = 1.0f / sqrtf(ssx * (1.0f / D) + pg8::RMS_EPS);
            GAS unsigned long long* o8 = (GAS unsigned long long*)(XN + (size_t)m * D) + lane;
            float dsum[8];
#pragma unroll
            for (int c = 0; c < 8; ++c) dsum[c] = 0.f;
#pragma unroll
            for (int j = 0; j < 4; ++j) {
                o8[64 * j] = (unsigned long long)pk2(v[j][0], v[j][1]) | ((unsigned long long)pk2(v[j][2], v[j][3]) << 32);
                v[j] = v[j] * rs * gv[j];
#pragma unroll
                for (int i = 0; i < 4; ++i)
#pragma unroll
                    for (int c = 0; c < 8; ++c) dsum[c] += v[j][i] * wba[j * 4 + i][c]; }
#pragma unroll
            for (int c = 0; c < 8; ++c) dsum[c] = wave_sum(dsum[c]);
            if (lane == 0) { ((float*)(F.ws + WS_SSQ0))[m] = ssx; *(GAS f32x4*)(BA + (size_t)m * 8) = (f32x4){dsum[0], dsum[1], dsum[2], dsum[3]}; *(GAS f32x4*)(BA + (size_t)m * 8 + 4) = (f32x4){dsum[4], dsum[5], dsum[6], dsum[7]}; }
        }
    }
    {
        f32x4 gv[4];
#pragma unroll
        for (int j = 0; j < 4; ++j) gv[j] = ((const f32x4*)F.g_mem)[lane + 64 * j];
        bf16* MN = (bf16*)(F.ws + WS_MN);
        for (int m = gw; m < MROWS; m += NGW) {
            const GAS f32x4* xr = (const GAS f32x4*)(F.mem + (size_t)m * D) + lane;
            f32x4 v[4]; float s = 0.f;
#pragma unroll
            for (int j = 0; j < 4; ++j) { v[j] = __builtin_nontemporal_load(xr + 64 * j); s += (v[j][0] * v[j][0] + v[j][1] * v[j][1]) + (v[j][2] * v[j][2] + v[j][3] * v[j][3]); }
            const float rs = 1.0f / sqrtf(wave_sum(s) * (1.0f / D) + pg8::RMS_EPS);
            GAS unsigned long long* o8 = (GAS unsigned long long*)(MN + (size_t)m * D) + lane;
#pragma unroll
            for (int j = 0; j < 4; ++j) { v[j] = v[j] * rs * gv[j]; o8[64 * j] = (unsigned long long)pk2(v[j][0], v[j][1]) | ((unsigned long long)pk2(v[j][2], v[j][3]) << 32); }
        }
    }
}

typedef short bf16x8v __attribute__((ext_vector_type(8)));
__device__ __forceinline__ f32x4 mfma16(bf16x8v x, bf16x8v y, f32x4 c) { return __builtin_amdgcn_mfma_f32_16x16x32_bf16(x, y, c, 0, 0, 0); }
constexpr int GA_QB = 0, GA_KB = 17408, GA_VB = 34816, GA_LM = 51200, GA_GC = 67584, GA_BT = GA_GC + 256, GA_EG = GA_BT + 256, GA_ED = GA_EG + 256;
constexpr int GA_SZ = GA_ED + 256;
constexpr int GQS = 136;
__device__ __forceinline__ v4u pack8(const float (&f)[8]) { v4u o; o.x = pk2(f[0], f[1]); o.y = pk2(f[2], f[3]); o.z = pk2(f[4], f[5]); o.w = pk2(f[6], f[7]); return o; }
__device__ __forceinline__ float bf2f(unsigned short h) { return __builtin_bit_cast(float, (unsigned)h << 16); }

template <int J, int H> struct SubHalf { static constexpr int G0 = (J + 1) >> 2, GLO = H ? (G0 > 8 ? G0 : 8) : (G0 < 8 ? G0 : 8), GHI = H ? 16 : 8, N = GHI - GLO; };
template <int J, int H> __device__ __forceinline__ void subst_load(f32x4 (&l)[8], const LAS float* LTv) {
    if constexpr (J < 63) {
        using P = SubHalf<J, H>;
#pragma unroll
        for (int g = 0; g < P::N; ++g) l[g] = *(const LAS f32x4*)(LTv + J * 64 + 4 * (P::GLO + g));
    }
}
typedef float f32x2v_ __attribute__((ext_vector_type(2)));
template <int J, int H> __device__ __forceinline__ void subst_fma(f32x2v_ (&R)[64], const f32x4 (&l)[8], const f32x2v_ x) {
    using P = SubHalf<J, H>;
#pragma unroll
    for (int g = 0; g < P::N; ++g)
#pragma unroll
        for (int e = 0; e < 4; ++e) { const int i = 4 * (P::GLO + g) + e; if (i > J) { const float lv = l[g][e]; R[i] = __builtin_elementwise_fma((f32x2v_){-lv, -lv}, x, R[i]); } }
}
template <int J> __device__ __forceinline__ void subst_step(f32x2v_ (&R)[64], f32x4 (&la)[8], f32x4 (&lb)[8], const LAS float* LTv) {
    const f32x2v_ x = R[J];
    subst_load<J, 1>(lb, LTv);
    subst_fma<J, 0>(R, la, x);
    __builtin_amdgcn_sched_barrier(0);
    subst_load<J + 1, 0>(la, LTv);
    subst_fma<J, 1>(R, lb, x);
    __builtin_amdgcn_sched_barrier(0);
}
template <int... Js> __device__ __forceinline__ void subst_all(f32x2v_ (&R)[64], f32x4 (&la)[8], f32x4 (&lb)[8], const LAS float* LTv, std::integer_sequence<int, Js...>) {
    (subst_step<Js>(R, la, lb, LTv), ...);
}

constexpr int GA_TB = 2 * GA_SZ;
static_assert(GA_TB + 4096 <= LDSCTL_OFF, "P2a LDS map");
__device__ __forceinline__ void p2a_tables(const Ctx& F, int pr, int tboff, int t128, const float* BA, float* GL) {
    if (t128 >= 0 && t128 < 128) {
        const int ch0 = 2 * pr, bh = ch0 >> 5, chunk0 = ch0 & 31, b = bh >> 2, h = bh & 3, p = t128 >> 6, t = t128 & 63;
        const size_t row0 = (size_t)b * SEQ + chunk0 * CHUNK;
        LAS float* gcs = (LAS float*)(F.lds + tboff + p * 1024);
        const float bb = BA[(row0 + t128) * 8 + h], aa = BA[(row0 + t128) * 8 + 4 + h] + F.dt_bias[h];
        const float sp = aa > 20.f ? aa : __logf(1.0f + __expf(aa));
        float gc = -__expf(F.a_log[h]) * sp;
#pragma unroll
        for (int o = 1; o < 64; o <<= 1) { const float tt = __builtin_bit_cast(float, __builtin_amdgcn_ds_bpermute(((t - o) & 63) << 2, __builtin_bit_cast(int, gc))); if (t >= o) gc += tt; }
        const float g63 = __builtin_bit_cast(float, __builtin_amdgcn_readlane(__builtin_bit_cast(int, gc), 63));
        gcs[t] = gc; gcs[64 + t] = 1.0f / (1.0f + __expf(-bb)); gcs[128 + t] = __expf(gc); gcs[192 + t] = __expf(g63 - gc);
        if (t == 63) GL[ch0 + p] = __expf(gc);
    }
}

#define P2A_LBAR() do { asm volatile("s_waitcnt lgkmcnt(0)" ::: "memory"); __builtin_amdgcn_s_barrier(); asm volatile("" ::: "memory"); } while (0)
__device__ __forceinline__ void p2a_prep_block(const Ctx& F, const int pr, const int tboff, const int tbk, const int cg, const bf16* PROJ, bf16* QG) {
    const int ch0 = 2 * pr, bh = ch0 >> 5, chunk0 = ch0 & 31, b = bh >> 2, h = bh & 3;
    const size_t row0 = (size_t)b * SEQ + chunk0 * CHUNK;
    const int p = tbk >> 4, tl0 = (4 * tbk) & 63, tok0 = chunk0 * CHUNK + 4 * tbk; const size_t rowb = row0 + 4 * tbk;
    LAS bf16* Qb = (LAS bf16*)(F.lds + p * GA_SZ + GA_QB); LAS bf16* Kb = (LAS bf16*)(F.lds + p * GA_SZ + GA_KB); LAS bf16* Vb = (LAS bf16*)(F.lds + p * GA_SZ + GA_VB);
    const LAS float* egs = (const LAS float*)(F.lds + tboff + p * 1024 + 512);
    v4u raw[3][7];
#pragma unroll
    for (int ty = 0; ty < 3; ++ty)
#pragma unroll
        for (int r = 0; r < 7; ++r) { const bool ok = tok0 - 3 + r >= 0; const size_t rr = ok ? rowb - 3 + r : rowb;
            v4u w = __builtin_nontemporal_load((const GAS v4u*)(PROJ + rr * NPROJ + 512 + 512 * ty + h * 128 + cg * 8));
            if (!ok) w = (v4u){0u, 0u, 0u, 0u};
            raw[ty][r] = w; }
    __builtin_amdgcn_sched_barrier(0);
    v4u qgp[4];
#pragma unroll
    for (int ty = 0; ty < 3; ++ty) {
        float wt[4][8], res[4][8];
#pragma unroll
        for (int i = 0; i < 4; ++i) { const f32x4* pw = (const f32x4*)(F.conv_w + (size_t)i * 1536 + 512 * ty + h * 128 + cg * 8); const f32x4 a0 = pw[0], a1 = pw[1];
#pragma unroll
            for (int e = 0; e < 4; ++e) { wt[i][e] = a0[e]; wt[i][4 + e] = a1[e]; } }
#pragma unroll
        for (int e = 0; e < 4; ++e)
#pragma unroll
            for (int c = 0; c < 8; ++c) res[e][c] = 0.f;
#pragma unroll
        for (int r = 0; r < 7; ++r) { float f[8]; unpack8(raw[ty][r], f);
#pragma unroll
            for (int e = 0; e < 4; ++e) { const int i = r - e; if (i >= 0 && i < 4) {
#pragma unroll
                    for (int c = 0; c < 8; ++c) res[e][c] += wt[i][c] * f[c]; } } }
#pragma unroll
        for (int e = 0; e < 4; ++e) { const int t = tl0 + e;
            float ss = 0.f;
#pragma unroll
            for (int c = 0; c < 8; ++c) { res[e][c] = silu_f(res[e][c]); ss += res[e][c] * res[e][c]; }
            if (ty == 0) { ss = row16_sum(ss); const float rq = (1.0f / sqrtf(ss + 1e-6f)) * 0.08838834764831845f, eg = egs[t]; float qg[8];
#pragma unroll
                for (int c = 0; c < 8; ++c) { res[e][c] *= rq; qg[c] = res[e][c] * eg; }
                *(LAS v4u*)(Qb + t * GQS + cg * 8) = pack8(res[e]); qgp[e] = pack8(qg); }
            else if (ty == 1) { ss = row16_sum(ss); const float rk = 1.0f / sqrtf(ss + 1e-6f);
#pragma unroll
                for (int c = 0; c < 8; ++c) res[e][c] *= rk;
                *(LAS v4u*)(Kb + t * GQS + cg * 8) = pack8(res[e]); }
            else *(LAS v4u*)(Vb + t * 128 + cg * 8) = pack8(res[e]);
        }
    }
#pragma unroll
    for (int e = 0; e < 4; ++e) *(GAS v4u*)(QG + (size_t)(ch0 + p) * 8192 + (tl0 + e) * 128 + cg * 8) = qgp[e];
}
__device__ __forceinline__ void p2a_tiles(const Ctx& F, const int pr, const int tboff, const int wave, const int r16, const int q4, bf16* AM) {
    const int ch0 = 2 * pr;
    for (int job = wave; job < 20; job += NWAVES) {
        const int p = job >= 10 ? 1 : 0, idx = job - 10 * p;
        const LAS bf16* Qb = (const LAS bf16*)(F.lds + p * GA_SZ + GA_QB); const LAS bf16* Kb = (const LAS bf16*)(F.lds + p * GA_SZ + GA_KB);
        LAS float* LT = (LAS float*)(F.lds + p * GA_SZ + GA_LM); const LAS float* gcs = (const LAS float*)(F.lds + tboff + p * 1024); const LAS float* bts = gcs + 64;
        const int ti = idx < 1 ? 0 : (idx < 3 ? 1 : (idx < 6 ? 2 : 3)), tj = idx - (ti * (ti + 1)) / 2;
        f32x4 accL = (f32x4){0.f, 0.f, 0.f, 0.f}, accA = accL;
#pragma unroll
        for (int s = 0; s < 4; ++s) { const bf16x8v ki = *(const LAS bf16x8v*)(Kb + (16 * ti + r16) * GQS + 32 * s + 8 * q4); const bf16x8v kj = *(const LAS bf16x8v*)(Kb + (16 * tj + r16) * GQS + 32 * s + 8 * q4);
            const bf16x8v qi = *(const LAS bf16x8v*)(Qb + (16 * ti + r16) * GQS + 32 * s + 8 * q4);
            accL = mfma16(ki, kj, accL);
            accA = mfma16(kj, qi, accA); }
        { const int j = 16 * tj + r16, i0 = 16 * ti + 4 * q4; const float gj = gcs[j];
          float val[4];
#pragma unroll
          for (int r = 0; r < 4; ++r) { const int i = i0 + r; const float e = __expf(fminf(gcs[i] - gj, 0.f)); val[r] = (j < i) ? bts[i] * accL[r] * e : 0.f; }
          *(LAS f32x4*)(LT + j * 64 + i0) = (f32x4){val[0], val[1], val[2], val[3]}; }
        { const int i = 16 * ti + r16, j0 = 16 * tj + 4 * q4; const float gi = gcs[i];
          float val[4];
#pragma unroll
          for (int r = 0; r < 4; ++r) { const int j = j0 + r; const float e = __expf(fminf(gi - gcs[j], 0.f)); val[r] = (j <= i) ? accA[r] * e : 0.f; }
          v2u w; w.x = pk2(val[0], val[1]); w.y = pk2(val[2], val[3]); *(GAS v2u*)(AM + (size_t)(ch0 + p) * 4096 + i * 64 + j0) = w; }
    }
    for (int job = NWAVES - 1 - wave; job < 12; job += NWAVES) {
        const int p = job >= 6 ? 1 : 0, u = job - 6 * p;
        const int ti = u < 3 ? 0 : (u < 5 ? 1 : 2), tj = u < 3 ? u + 1 : (u < 5 ? u - 1 : 3);
        *(GAS v2u*)(AM + (size_t)(ch0 + p) * 4096 + (16 * ti + r16) * 64 + 16 * tj + 4 * q4) = (v2u){0u, 0u};
    }
}

__device__ __forceinline__ void p2a_gdn_chunks(const Ctx& F) {
    PHASE_TID();
#define P2A_WS(name) unsigned char* name = F.ws; asm volatile("" : "+s"(name))
    constexpr int NPAIR = BATCH * DNH * (SEQ / CHUNK) / 2;
    const int tid0 = tid;
    const bool solver = wave < 4;
    if (F.vcu >= NPAIR) return;
    { P2A_WS(w0); p2a_tables(F, F.vcu, GA_TB, tid0, (const float*)(w0 + WS_BA), (float*)(w0 + WS_GGL)); }
    __syncthreads();
    { P2A_WS(w0); int tl_ = tid0; asm volatile("" : "+v"(tl_)); p2a_prep_block(F, F.vcu, GA_TB, tl_ >> 4, tl_ & 15, (const bf16*)(w0 + WS_C), (bf16*)(w0 + WS_GQG)); }
    __syncthreads();
    { P2A_WS(w0); int tl_ = tid0; asm volatile("" : "+v"(tl_)); p2a_tiles(F, F.vcu, GA_TB, wave, tl_ & 15, (tl_ & 63) >> 4, (bf16*)(w0 + WS_GAM)); }
    __syncthreads();
    int itn = 0;
    for (int pr = F.vcu; pr < NPAIR; pr += F.G, ++itn) {
        const int tb_off = GA_TB + (itn & 1) * 2048, tb_nxt = GA_TB + ((itn + 1) & 1) * 2048;
        const bool has_next = pr + F.G < NPAIR;
        const int ch0 = 2 * pr;
        int t3_ = tid0; asm volatile("" : "+v"(t3_));
        if (solver) {
            const int p = t3_ >> 7, c = t3_ & 127;
            const LAS bf16* Kb = (const LAS bf16*)(F.lds + p * GA_SZ + GA_KB); const LAS bf16* Vb = (const LAS bf16*)(F.lds + p * GA_SZ + GA_VB);
            LAS bf16* Wl = (LAS bf16*)(F.lds + p * GA_SZ + GA_LM);
            unsigned lmv = (unsigned)(size_t)(F.lds + p * GA_SZ + GA_LM), gcv = (unsigned)(size_t)(F.lds + tb_off + p * 1024); asm volatile("" : "+v"(lmv), "+v"(gcv));
            const LAS float* LTv = (const LAS float*)lmv; const LAS float* btv = (const LAS float*)(gcv + 256); const LAS float* egv = (const LAS float*)(gcv + 512); const LAS float* edv = (const LAS float*)(gcv + 768);
            const size_t chp = (size_t)(ch0 + p);
            P2A_WS(w1); bf16* KDT = (bf16*)(w1 + WS_GKD);
            f32x2v_ R[64];
#pragma unroll
            for (int i = 0; i < 64; ++i) { const float bt = btv[i]; R[i] = (f32x2v_){bt * bf2f(Vb[i * 128 + c]), bt * egv[i] * bf2f(Kb[i * GQS + c])};
                asm volatile("" : "+v"(R[i]));
                if ((i & 7) == 7) __builtin_amdgcn_sched_barrier(0); }
#pragma unroll
            for (int g8 = 0; g8 < 8; ++g8) { float kd[8];
#pragma unroll
                for (int e = 0; e < 8; ++e) kd[e] = bf2f(Kb[(8 * g8 + e) * GQS + c]) * edv[8 * g8 + e];
                *(GAS v4u*)(KDT + chp * 8192 + c * 64 + 8 * g8) = pack8(kd);
                __builtin_amdgcn_sched_barrier(0); }
            P2A_LBAR();
            f32x4 la[8], lb[8];
            subst_load<0, 0>(la, LTv);
            subst_all(R, la, lb, LTv, std::make_integer_sequence<int, 63>{});
            P2A_LBAR();
            P2A_WS(w3); bf16* UT = (bf16*)(w3 + WS_GUT);
#pragma unroll
            for (int g8 = 0; g8 < 8; ++g8) { v4u o; o.x = pk2(R[8 * g8].x, R[8 * g8 + 1].x); o.y = pk2(R[8 * g8 + 2].x, R[8 * g8 + 3].x); o.z = pk2(R[8 * g8 + 4].x, R[8 * g8 + 5].x); o.w = pk2(R[8 * g8 + 6].x, R[8 * g8 + 7].x);
                *(GAS v4u*)(UT + chp * 8192 + c * 64 + 8 * g8) = o; }
#pragma unroll
            for (int i = 0; i < 64; ++i) Wl[i * 128 + c] = (bf16)f2bf(-R[i].y);
        } else {
            const int tp = t3_ - 256;
            if (has_next) { P2A_WS(w1); p2a_tables(F, pr + F.G, tb_nxt, tp, (const float*)(w1 + WS_BA), (float*)(w1 + WS_GGL)); }
            P2A_LBAR();
            if (has_next) {
#pragma unroll 1
                for (int pass = 0; pass < 2; ++pass) { P2A_WS(w2); int tq_ = tp; asm volatile("" : "+v"(tq_));
                    p2a_prep_block(F, pr + F.G, tb_nxt, (tq_ >> 4) + 16 * pass, tq_ & 15, (const bf16*)(w2 + WS_C), (bf16*)(w2 + WS_GQG)); }
            }
            P2A_LBAR();
        }
        P2A_LBAR();
        { P2A_WS(w4); bf16* WM = (bf16*)(w4 + WS_GWM); int tl_ = tid0; asm volatile("" : "+v"(tl_));
#pragma unroll
          for (int k = 0; k < 4; ++k) { const int idx = tl_ + 512 * k, p = idx >> 10, id = idx & 1023;
              *(GAS v4u*)(WM + (size_t)(ch0 + p) * 8192 + id * 8) = *(const LAS v4u*)((const LAS bf16*)(F.lds + p * GA_SZ + GA_LM) + id * 8); } }
        P2A_LBAR();
        if (has_next) { P2A_WS(w5); int tl_ = tid0; asm volatile("" : "+v"(tl_)); p2a_tiles(F, pr + F.G, tb_nxt, wave, tl_ & 15, (tl_ & 63) >> 4, (bf16*)(w5 + WS_GAM)); }
        P2A_LBAR();
    }
}
#undef P2A_WS
#undef P2A_LBAR

__device__ __forceinline__ void p2b_gdn_scan(const Ctx& F) {
    PHASE_TID();
    constexpr int STS = 136, VNS = 72;
    constexpr int OP0 = 32 * STS * 2 + 32 * VNS * 2;
    constexpr int O_WM = 0, O_QG = 64 * 272, O_AM = 2 * 64 * 272, O_KD = O_AM + 64 * 144, OPB = O_KD + 128 * 144;
    static_assert(OP0 + 2 * OPB <= LDSCTL_OFF, "scan LDS map");
    LAS bf16* ST = (LAS bf16*)F.lds; LAS bf16* VN = (LAS bf16*)(F.lds + 32 * STS * 2);
    const bf16* WM = (const bf16*)(F.ws + WS_GWM); const bf16* UT = (const bf16*)(F.ws + WS_GUT); const bf16* QG = (const bf16*)(F.ws + WS_GQG); const bf16* KDT = (const bf16*)(F.ws + WS_GKD);
    const bf16* AM = (const bf16*)(F.ws + WS_GAM); const float* GL = (const float*)(F.ws + WS_GGL); bf16* OR = (bf16*)(F.ws + WS_OR);
    const int q4 = lane >> 4, r16 = lane & 15, it_ = wave >> 1, dt = wave & 1;
    struct Stage { v4u g[7]; v2u ut; float gl; };
    unsigned lw[7];
#pragma unroll
    for (int k = 0; k < 2; ++k) { const int i = tid + 512 * k; lw[k] = O_WM + (i >> 4) * 272 + (i & 15) * 16; lw[2 + k] = O_QG + (i >> 4) * 272 + (i & 15) * 16; lw[5 + k] = O_KD + (i >> 3) * 144 + (i & 7) * 16; }
    lw[4] = O_AM + (tid >> 3) * 144 + (tid & 7) * 16;
    for (int item = F.vcu; item < BATCH * DNH * 4; item += F.G) {
        const int b = item >> 4, h = (item >> 2) & 3, dvq = item & 3;
        const int ch0 = (b * 4 + h) * 32;
        for (int idx = tid; idx < 32 * STS / 2; idx += NWAVES * 64) ((LAS unsigned*)ST)[idx] = 0u;
        f32x4 Sacc[2]; Sacc[0] = (f32x4){0.f, 0.f, 0.f, 0.f}; Sacc[1] = Sacc[0];
#define GDN_ISSUE(S, chx) do { const size_t cb = (size_t)(chx); \
            _Pragma("unroll") for (int k = 0; k < 2; ++k) { (S).g[k] = *(const GAS v4u*)(WM + cb * 8192 + (size_t)(tid + 512 * k) * 8); (S).g[2 + k] = *(const GAS v4u*)(QG + cb * 8192 + (size_t)(tid + 512 * k) * 8); \
                (S).g[5 + k] = *(const GAS v4u*)(KDT + cb * 8192 + (size_t)(tid + 512 * k) * 8); } \
            (S).g[4] = *(const GAS v4u*)(AM + cb * 4096 + (size_t)tid * 8); \
            (S).ut = *(const GAS v2u*)(UT + cb * 8192 + (dvq * 32 + 16 * dt + r16) * 64 + 16 * it_ + 4 * q4); (S).gl = GL[cb]; } while (0)
#define GDN_WRITE(S, buf) do { _Pragma("unroll") for (int k = 0; k < 7; ++k) *(LAS v4u*)(F.lds + OP0 + (buf) * OPB + lw[k]) = (S).g[k]; } while (0)
#define GDN_LBAR() do { asm volatile("s_waitcnt lgkmcnt(0)" ::: "memory"); __builtin_amdgcn_s_barrier(); asm volatile("" ::: "memory"); } while (0)
        Stage S0, S1, S2;
        GDN_ISSUE(S0, ch0); GDN_ISSUE(S1, ch0 + 1); GDN_ISSUE(S2, ch0 + 2); GDN_WRITE(S0, 0);
        GDN_LBAR();
#define GDN_STEP(SC, SW, cc) do { const int c = (cc); const int bufc = c & 1; \
            const v2u utc = (SC).ut; const float glc = (SC).gl; \
            { const int cl = (c + 3 < SEQ / CHUNK) ? c + 3 : SEQ / CHUNK - 1; GDN_ISSUE(SC, ch0 + cl); } \
            const LAS unsigned char* ob = F.lds + OP0 + bufc * OPB; \
            bf16x8v sf[4], wf[4], qf[4]; \
            _Pragma("unroll") for (int s = 0; s < 4; ++s) { sf[s] = *(const LAS bf16x8v*)(ST + (16 * dt + r16) * STS + 32 * s + 8 * q4); \
                wf[s] = *(const LAS bf16x8v*)(ob + O_WM + (16 * it_ + r16) * 272 + (32 * s + 8 * q4) * 2); qf[s] = *(const LAS bf16x8v*)(ob + O_QG + (16 * it_ + r16) * 272 + (32 * s + 8 * q4) * 2); } \
            f32x4 vacc = (f32x4){bflo(utc.x), bfhi(utc.x), bflo(utc.y), bfhi(utc.y)}; \
            f32x4 oacc = (f32x4){0.f, 0.f, 0.f, 0.f}; \
            _Pragma("unroll") for (int s = 0; s < 4; ++s) { vacc = mfma16(wf[s], sf[s], vacc); oacc = mfma16(sf[s], qf[s], oacc); } \
            { v2u w; w.x = pk2(vacc[0], vacc[1]); w.y = pk2(vacc[2], vacc[3]); *(LAS v2u*)(VN + (16 * dt + r16) * VNS + 16 * it_ + 4 * q4) = w; } \
            GDN_LBAR(); \
            bf16x8v vf[2][2], af[2], kf[2]; \
            _Pragma("unroll") for (int s = 0; s < 2; ++s) { af[s] = *(const LAS bf16x8v*)(ob + O_AM + (16 * it_ + r16) * 144 + (32 * s + 8 * q4) * 2); kf[s] = *(const LAS bf16x8v*)(ob + O_KD + (16 * wave + r16) * 144 + (32 * s + 8 * q4) * 2); } \
            _Pragma("unroll") for (int t = 0; t < 2; ++t) _Pragma("unroll") for (int s = 0; s < 2; ++s) vf[t][s] = *(const LAS bf16x8v*)(VN + (16 * t + r16) * VNS + 32 * s + 8 * q4); \
            _Pragma("unroll") for (int s = 0; s < 2; ++s) { const bf16x8v vo = *(const LAS bf16x8v*)(VN + (16 * dt + r16) * VNS + 32 * s + 8 * q4); oacc = mfma16(vo, af[s], oacc); } \
            { v2u w; w.x = pk2(oacc[0], oacc[1]); w.y = pk2(oacc[2], oacc[3]); *(GAS v2u*)(OR + ((size_t)b * SEQ + c * CHUNK + 16 * it_ + r16) * DNW + h * 128 + dvq * 32 + 16 * dt + 4 * q4) = w; } \
            _Pragma("unroll") for (int t = 0; t < 2; ++t) { Sacc[t] = Sacc[t] * glc; \
                _Pragma("unroll") for (int s = 0; s < 2; ++s) Sacc[t] = mfma16(kf[s], vf[t][s], Sacc[t]); \
                v2u w; w.x = pk2(Sacc[t][0], Sacc[t][1]); w.y = pk2(Sacc[t][2], Sacc[t][3]); *(LAS v2u*)(ST + (16 * t + r16) * STS + 16 * wave + 4 * q4) = w; } \
            GDN_WRITE(SW, bufc ^ 1); \
            GDN_LBAR(); \
        } while (0)
#pragma unroll 1
        for (int c3 = 0; c3 < SEQ / CHUNK; c3 += 3) { GDN_STEP(S0, S1, c3); if (c3 + 1 < SEQ / CHUNK) GDN_STEP(S1, S2, c3 + 1); if (c3 + 2 < SEQ / CHUNK) GDN_STEP(S2, S0, c3 + 2); }
#undef GDN_STEP
#undef GDN_LBAR
#undef GDN_WRITE
#undef GDN_ISSUE
    }
}

__device__ __forceinline__ void p3_mixer_finish(const Ctx& F) {
    PHASE_TID();
    const int gw = F.vcu * NWAVES + wave, NGW = F.G * NWAVES;
    const bf16* PROJ = (const bf16*)(F.ws + WS_C); const bf16* OR = (const bf16*)(F.ws + WS_OR); bf16* Y = (bf16*)(F.ws + WS_Y);
    const int c0 = lane * 8, grp = lane >> 4, win = 2 << grp;
    float gn[8];
    { const f32x4* p = (const f32x4*)(F.g_dn + (c0 & 127)); const f32x4 a = p[0], b = p[1];
#pragma unroll
      for (int e = 0; e < 4; ++e) { gn[e] = a[e]; gn[4 + e] = b[e]; } }
    for (int blk = gw; blk < M / 4; blk += NGW) {
        const int m0 = blk * 4, tok0 = m0 & (SEQ - 1);
        v4u wl[19], zw[4], ow[4];
#pragma unroll
        for (int r = 0; r < 19; ++r) { const int back = 15 - r; const size_t rr = (tok0 - back >= 0) ? (size_t)(m0 - back) : (size_t)m0; wl[r] = *(const GAS v4u*)(PROJ + rr * NPROJ + c0); }
#pragma unroll
        for (int e = 0; e < 4; ++e) { zw[e] = __builtin_nontemporal_load((const GAS v4u*)(PROJ + (size_t)(m0 + e) * NPROJ + 2048 + c0)); ow[e] = __builtin_nontemporal_load((const GAS v4u*)(OR + (size_t)(m0 + e) * DNW + c0)); }
        float S[8];
#pragma unroll
        for (int c = 0; c < 8; ++c) S[c] = 0.f;
        { const int cnt0 = (tok0 + 1) < win ? (tok0 + 1) : win;
#pragma unroll
          for (int i = 0; i < 16; ++i) { float f[8]; unpack8(wl[15 - i], f); const bool on = i < cnt0;
#pragma unroll
              for (int c = 0; c < 8; ++c) S[c] += on ? f[c] : 0.f; } }
#pragma unroll
        for (int e = 0; e < 4; ++e) {
            float u0[8]; unpack8(wl[15 + e], u0);
            if (e > 0) {
                const v4u sel = win == 2 ? wl[13 + e] : (win == 4 ? wl[11 + e] : (win == 8 ? wl[7 + e] : wl[e > 0 ? e - 1 : 0]));
                float fs[8]; unpack8(sel, fs); const bool sub = tok0 + e - win >= 0;
#pragma unroll
                for (int c = 0; c < 8; ++c) S[c] += u0[c] - (sub ? fs[c] : 0.f);
            }
            const int tk = tok0 + e; const int cnt = (tk + 1) < win ? (tk + 1) : win; const float ic = 1.0f / (float)cnt;
            v4u o; o.x = pk2(S[0] * ic - u0[0], S[1] * ic - u0[1]); o.y = pk2(S[2] * ic - u0[2], S[3] * ic - u0[3]); o.z = pk2(S[4] * ic - u0[4], S[5] * ic - u0[5]); o.w = pk2(S[6] * ic - u0[6], S[7] * ic - u0[7]);
            *(GAS v4u*)(Y + (size_t)(m0 + e) * D + c0) = o;
            float ov[8]; unpack8(ow[e], ov);
            float ss = 0.f;
#pragma unroll
            for (int c = 0; c < 8; ++c) ss += ov[c] * ov[c];
            ss = row16_sum(ss);
            const float rs = 1.0f / sqrtf(ss * (1.0f / 128.0f) + 1e-6f);
            float z[8]; unpack8(zw[e], z);
            float y[8];
#pragma unroll
            for (int c = 0; c < 8; ++c) y[c] = ov[c] * rs * gn[c] * silu_f(z[c]);
            v4u o2; o2.x = pk2(y[0], y[1]); o2.y = pk2(y[2], y[3]); o2.z = pk2(y[4], y[5]); o2.w = pk2(y[6], y[7]);
            *(GAS v4u*)(Y + (size_t)(m0 + e) * D + 512 + c0) = o2;
        }
    }
}

__device__ __forceinline__ void p10_final_norm(const Ctx& F) {
    PHASE_TID();
    const int gw = F.vcu * NWAVES + wave, NGW = F.G * NWAVES;
    f32x4 gv[4];
#pragma unroll
    for (int j = 0; j < 4; ++j) gv[j] = ((const f32x4*)F.g_fin)[lane + 64 * j];
    for (int m = gw; m < M; m += NGW) {
        GAS f32x4* xr = (GAS f32x4*)(F.out + (size_t)m * D) + lane;
        f32x4 v[4]; float s = 0.f;
#pragma unroll
        for (int j = 0; j < 4; ++j) { v[j] = xr[64 * j]; s += (v[j][0] * v[j][0] + v[j][1] * v[j][1]) + (v[j][2] * v[j][2] + v[j][3] * v[j][3]); }
        const float rs = 1.0f / sqrtf(wave_sum(s) * (1.0f / D) + pg8::RMS_EPS);
#pragma unroll
        for (int j = 0; j < 4; ++j) xr[64 * j] = v[j] * rs * gv[j];
    }
}

struct Args { const float* in[21]; float* out; unsigned char* ws; int ph_lo, ph_hi, li, pad; };
__global__ void __launch_bounds__(NWAVES * 64, 2) hymba_fwd(Args args) {
    extern __shared__ __attribute__((aligned(16))) unsigned char lds[];
    Ctx F;
    F.lds = (LAS unsigned char*)lds;
    volatile LAS unsigned* MISC = (volatile LAS unsigned*)(F.lds + MISC_OFF);
    F.G = gridDim.x; { const int bx = blockIdx.x; F.vcu = (F.G % 8 == 0) ? (bx % 8) * (F.G / 8) + bx / 8 : bx; }
    F.x = args.in[0]; F.mem = args.in[1]; F.g_mix = args.in[2]; F.w_in = args.in[3]; F.w_pool = args.in[4]; F.pool_scale = args.in[5]; F.conv_w = args.in[6]; F.a_log = args.in[7];
    F.dt_bias = args.in[8]; F.g_dn = args.in[9]; F.w_out = args.in[10]; F.g_xa = args.in[11]; F.g_mem = args.in[12]; F.w_xq = args.in[13]; F.w_xk = args.in[14]; F.w_xv = args.in[15];
    F.w_xo = args.in[16]; F.g_mlp = args.in[17]; F.w_up = args.in[18]; F.w_down = args.in[19]; F.g_fin = args.in[20];
    F.out = args.out; F.ws = args.ws;
    unsigned char* ws = args.ws;
    gu32* ctl = (gu32*)(ws + WS_CTL);
    for (int u = threadIdx.x; u < (LDS_BYTES - LDSCTL_OFF) / 4; u += NWAVES * 64) ((LAS unsigned*)(F.lds + LDSCTL_OFF))[u] = 0u;
    __syncthreads();
    XcdBarrier bar; bar.bar = (unsigned*)(ctl + CW_BAR); bar.x = 0; bar.st = nullptr;
    if (N_LAUNCHES == 1) bar = xcd_barrier_post((unsigned*)(ctl + CW_BAR), MISC + 8);
#define GRID_BAR() do { if (N_LAUNCHES == 1) { xcd_barrier(bar); if (PROBE_REP == 100) xcd_barrier(bar); } } while (0)
    const int lo = args.ph_lo, hi = args.ph_hi;
#define IN(k) (lo <= (k) && (k) < hi)
#define NREP(k) ((PROBE_REP == (k)) ? 2 : 1)
#define BOTH(k) (IN(k) && IN((k) + 1))
    using namespace pg8;
    bf16_t* WIN = (bf16_t*)(ws + WS_WIN); bf16_t* WOUT = (bf16_t*)(ws + WS_WOUT); bf16_t* WQ = (bf16_t*)(ws + WS_WQ); bf16_t* WK = (bf16_t*)(ws + WS_WK);
    bf16_t* WV = (bf16_t*)(ws + WS_WV); bf16_t* WO = (bf16_t*)(ws + WS_WO); bf16_t* WUP = (bf16_t*)(ws + WS_WUP); bf16_t* WDN = (bf16_t*)(ws + WS_WDN);
    bf16_t* MN = (bf16_t*)(ws + WS_MN); bf16_t* KM = (bf16_t*)(ws + WS_KM); bf16_t* VT = (bf16_t*)(ws + WS_VT);
    bf16_t* RA = (bf16_t*)(ws + WS_A); bf16_t* RB = (bf16_t*)(ws + WS_B); bf16_t* RC = (bf16_t*)(ws + WS_C); bf16_t* PS = (bf16_t*)(ws + WS_PS);
    float* SSQ1 = (float*)(ws + WS_SSQ1); float* SSQ2 = (float*)(ws + WS_SSQ2); float* SSQ3 = (float*)(ws + WS_SSQ3);
    const int bx = (int)blockIdx.x;

    if (IN(0)) { for (int rep = 0; rep < NREP(0); ++rep) { p0_prologue(F); __syncthreads(); } if (BOTH(0)) GRID_BAR(); }
    if (IN(1)) {
        for (int rep = 0; rep < NREP(1); ++rep) {
        { Gemm g{RA, WIN, 1024, 1024, 1024}; StaticOrder S; S.init(M, NPROJ, F.G, bx); EpiStore<0, true> E{RC, NPROJ, (const float*)(ws + WS_SSQ0)};
          gemm_phase<EpiStore<0, true>, StaticOrder, true, true>(F.lds, g, S, E); }
        { Gemm g{MN, WK, 1024, 1024, 1024}; StaticOrder S; S.init(MROWS, 1024, F.G, bx); EpiStore<0, false> E{KM, 1024, nullptr};
          gemm_phase<EpiStore<0, false>, StaticOrder, true, true>(F.lds, g, S, E); }
        { Gemm g{WV, MN, 1024, 1024, 1024}; StaticOrder S; S.init(1024, MROWS, F.G, (bx + F.G / 2) % F.G); EpiStore<0, false> E{VT, MROWS, nullptr};
          gemm_phase<EpiStore<0, false>, StaticOrder, true, true>(F.lds, g, S, E); }
        }
        { const int q = F.G / 4; const int seg = bx / q; if ((seg & 1) && F.G % 4 == 0) late_weight_copies(F, (seg >> 1) * q + (bx - seg * q), 2 * q); else if (F.G % 4 != 0 && bx == 0) {   } }
        if (F.G % 4 != 0) late_weight_copies(F, bx, F.G);
        if (BOTH(1)) GRID_BAR();
    }
    if (IN(2)) { for (int rep = 0; rep < NREP(2); ++rep) { p2a_gdn_chunks(F); __syncthreads(); } if (BOTH(2)) GRID_BAR(); }
    if (IN(3)) { for (int rep = 0; rep < NREP(3); ++rep) { p2b_gdn_scan(F); __syncthreads(); } if (BOTH(3)) GRID_BAR(); }
    if (IN(4)) { for (int rep = 0; rep < NREP(4); ++rep) { p3_mixer_finish(F); __syncthreads(); } if (BOTH(4)) GRID_BAR(); }
    if (IN(5)) {
        Gemm g{(const bf16_t*)(ws + WS_Y), WOUT, 1024, 1024, 1024}; StaticOrder S; S.init(M, D, F.G, bx); EpiResid<0> E{(const float*)RA, RB, SSQ1, nullptr, nullptr, nullptr};
        gemm_phase<EpiResid<0>, StaticOrder, true, true>(F.lds, g, S, E);
        if (BOTH(5)) GRID_BAR();
    }
    if (IN(7)) {
        for (int rep = 0; rep < NREP(7); ++rep)
        for (int u0 = F.vcu; u0 < (M / 256) * 4; u0 += 2 * F.G) {
            const int u1 = u0 + F.G, nu = (u1 < (M / 256) * 4) ? 2 : 1;
            const int rt0 = u0 >> 2, h0 = u0 & 3, b0 = rt0 >> 3, rt1 = (nu > 1 ? u1 : u0) >> 2, h1 = (nu > 1 ? u1 : u0) & 3, b1 = rt1 >> 3;
            { Gemm g{RB, WQ, 1024, 1024, 1024}; PairUnits S{Unit{rt0, h0, 0, 0, 0}, Unit{rt1, h1, 0, 0, 0}, nu}; EpiStore<0, true> E{RC, 1024, SSQ1};
              gemm_phase<EpiStore<0, true>, PairUnits, true, true>(F.lds, g, S, E); }
            VM_WAIT(); __syncthreads();
            { Gemm g{RC, KM, 1024, 1024, 256}; PairUnits S{Unit{rt0, b0, (long)h0 * 512, (long)h0 * 512, u0}, Unit{rt1, b1, (long)h1 * 512, (long)h1 * 512, nu > 1 ? u1 : u0}, nu};
              EpiSoftmaxS E{PS, 0.0625f * 1.4426950408889634f, F.lds + RING_BYTES};
              gemm_phase<EpiSoftmaxS, PairUnits, true, true>(F.lds, g, S, E); }
            VM_WAIT(); __syncthreads();
            { Gemm g{PS, VT, 256, MROWS, 256};
              PairUnits S{Unit{rt0, h0, (long)u0 * 131072 - (long)rt0 * 131072, (long)b0 * 512, 0}, Unit{rt1, h1, (long)(nu > 1 ? u1 : u0) * 131072 - (long)rt1 * 131072, (long)b1 * 512, 0}, nu};
              EpiStore<0, false> E{RA, 1024, nullptr};
              gemm_phase<EpiStore<0, false>, PairUnits, true, true>(F.lds, g, S, E); }
            __syncthreads();
        }
        if (BOTH(7)) GRID_BAR();
    }
    if (IN(8)) {
        Gemm g{RA, WO, 1024, 1024, 1024}; StaticOrder S; S.init(M, D, F.G, bx); EpiResid<1> E{nullptr, RB, SSQ2, nullptr, nullptr, nullptr};
        gemm_phase<EpiResid<1>, StaticOrder, true, true>(F.lds, g, S, E);
        if (BOTH(8)) GRID_BAR();
    }
    if (IN(9)) {
        Gemm g{RB, WUP, 1024, 1024, 1024}; StaticOrder S; S.init(M, FF, F.G, bx); EpiStore<1, true> E{RC, FF, SSQ2};
        for (int rep = 0; rep < NREP(9); ++rep) gemm_phase<EpiStore<1, true>, StaticOrder, true, true>(F.lds, g, S, E);
        if (BOTH(9)) GRID_BAR();
    }
    if (IN(10)) {
        Gemm g{RC, WDN, 64, FF, FF, (size_t)32768, (size_t)(FF / 64) * 32768};     StaticOrder S; S.init(M, D, F.G, bx); EpiResid<2> E{nullptr, RB, SSQ3, F.out, F.g_fin, (unsigned*)(ws + WS_CNT3)};
        gemm_phase<EpiResid<2>, StaticOrder, true, true>(F.lds, g, S, E);
    }
#undef IN
#undef BOTH
}

extern "C" void kernel_launch(void* const* d_in, const int* in_sizes, int n_in, void* d_out, int out_size, void* d_ws, size_t ws_size, hipStream_t stream) {
    static int grid = 0;
    if (grid == 0) {
        if (n_in != 21 || in_sizes[0] != M * D || out_size != M * D || ws_size < WS_END) { fprintf(stderr, "kernel_launch: unexpected shapes (n_in %d, in0 %d, out %d, ws %zu); nothing launched\n", n_in, n_in > 0 ? in_sizes[0] : -1, out_size, ws_size); grid = -1; return; }
        int dev = 0, cus = 0, per_cu = 0;
        if (hipGetDevice(&dev) != hipSuccess || hipDeviceGetAttribute(&cus, hipDeviceAttributeMultiprocessorCount, dev) != hipSuccess) { fprintf(stderr, "kernel_launch: device query failed\n"); grid = -1; return; }
        if (hipFuncSetAttribute((const void*)hymba_fwd, hipFuncAttributeMaxDynamicSharedMemorySize, LDS_BYTES) != hipSuccess) { fprintf(stderr, "kernel_launch: hipFuncSetAttribute failed\n"); grid = -1; return; }
        if (hipOccupancyMaxActiveBlocksPerMultiprocessor(&per_cu, (const void*)hymba_fwd, NWAVES * 64, LDS_BYTES) != hipSuccess || per_cu < 1) { fprintf(stderr, "kernel_launch: occupancy query reports %d blocks per CU\n", per_cu); per_cu = 1; }
        (void)hipGetLastError();
        grid = cus;
    }
    if (grid < 0) return;
    if (hipMemsetAsync((char*)d_ws + WS_CTL, 0, CTL_ZERO_BYTES, stream) != hipSuccess) { fprintf(stderr, "kernel_launch: memset failed\n"); return; }
    Args a{};
    for (int i = 0; i < 21; ++i) a.in[i] = (const float*)d_in[i];
    a.out = (float*)d_out; a.ws = (unsigned char*)d_ws;
    for (int li = 0; li < N_LAUNCHES; ++li) {
        a.ph_lo = (N_LAUNCHES == 1) ? 0 : li; a.ph_hi = (N_LAUNCHES == 1) ? N_PHASES : li + 1; a.li = li;
        hipLaunchKernelGGL(hymba_fwd, dim3(grid), dim3(NWAVES * 64), LDS_BYTES, stream, a);
        const hipError_t le = hipPeekAtLastError();
        if (le != hipSuccess) { fprintf(stderr, "kernel_launch: launch %d failed: %s\n", li, hipGetErrorName(le)); break; }
    }
}
```

```cpp
#include <hip/hip_runtime.h>
#include <cstdio>
#include <cstdint>
#include <utility>

#ifndef PROBE_REP
#define PROBE_REP -1
#endif
#ifndef MK_N_LAUNCHES
#define MK_N_LAUNCHES 1
#endif

namespace pg8 {
#define PG8_LAS __attribute__((address_space(3)))
typedef unsigned short bf16_t;
typedef short bf16x8 __attribute__((ext_vector_type(8)));
typedef float f32x4 __attribute__((ext_vector_type(4)));
typedef unsigned u32x4 __attribute__((ext_vector_type(4)));
typedef unsigned u32x2 __attribute__((ext_vector_type(2)));
constexpr int BM = 256, BK = 64, HALF = 128, HTB = HALF * BK * 2  , STAGE_BYTES = 8 * HTB, NXCD = 8, WGM = 4;

__host__ __device__ __forceinline__ int lds_byte(int r, int c) { const int st = (r >> 4) * 2 + (c >> 5), rr = r & 15, cc = c & 31, ob = rr * 64 + cc * 2; return st * 1024 + (ob ^ (((ob >> 9) & 1) << 5)); }
__host__ __device__ __forceinline__ void stage_rc(int b, int& R, int& C) { const int st = b / 1024, sb = b % 1024, swz = sb ^ (((sb >> 9) & 1) << 5); R = (st >> 1) * 16 + swz / 64; C = (st & 1) * 32 + (swz % 64) / 2; }
__host__ __device__ __forceinline__ int perm32(int rho) { const int n = rho >> 4, i = rho & 15; return 8 * (i >> 2) + 4 * n + (i & 3); }

struct Unit { int pm, pn; long ao, bo; int id; };
struct Gemm { const bf16_t* A; const bf16_t* Bt; int lda, ldb, K; size_t akstep = 0, atstep = 0; };

struct StaticOrder {
    int nM, nN, nwg, G, c;
    __host__ __device__ void init(int M, int N, int G_, int c_) { nM = M / BM; nN = N / BM; nwg = nM * nN; G = G_; c = c_; }
    __host__ __device__ bool next(int i, Unit& u) const {
        const long L = (long)i * G + c; if (L >= nwg) return false;
        int wgid = (int)L; { const int q = nwg / NXCD, r = nwg % NXCD, xcd = wgid % NXCD, off = wgid / NXCD; wgid = (xcd < r ? xcd * (q + 1) : r * (q + 1) + (xcd - r) * q) + off; }
        const int nig = WGM * nN, gid = wgid / nig, fm = gid * WGM, gsz = (nM - fm) < WGM ? (nM - fm) : WGM;
        u.pm = fm + ((wgid % nig) % gsz); u.pn = (wgid % nig) / gsz; u.ao = 0; u.bo = 0; u.id = 0; return true;
    }
    __device__ __forceinline__ void a_ready(const Unit&) const {}
    __device__ __forceinline__ void done(const Unit&) const {}
};
struct OneUnit {
    int pm, pn;
    __device__ __forceinline__ bool next(int i, Unit& u) const { if (i != 0) return false; u.pm = pm; u.pn = pn; u.ao = 0; u.bo = 0; u.id = 0; return true; }
    __device__ __forceinline__ void a_ready(const Unit&) const {}
    __device__ __forceinline__ void done(const Unit&) const {}
};

struct PairUnits {
    Unit u0, u1; int n;
    __device__ __forceinline__ bool next(int i, Unit& u) const { if (i >= n) return false; u = i ? u1 : u0; return true; }
    __device__ __forceinline__ void a_ready(const Unit&) const {}
    __device__ __forceinline__ void done(const Unit&) const {}
};

__device__ __forceinline__ unsigned cvt_pk_bf16(float lo, float hi) { unsigned r; asm volatile("v_cvt_pk_bf16_f32 %0, %1, %2" : "=v"(r) : "v"(lo), "v"(hi)); return r; }

constexpr float RMS_EPS = 1e-6f;
__device__ __forceinline__ float rs_from_ssq(const float* ssq, int row) { return 1.0f / sqrtf(ssq[row] * (1.0f / 1024.0f) + RMS_EPS); }

template <int ACT, bool RS> struct EpiStore {
    static constexpr bool PERM = true, AFTER_DRAIN = false;
    bf16_t* O; int ldc; const float* ssq;
    __device__ __forceinline__ void operator()(const f32x4 (&acc)[2][2][4][2], const Unit& u, int wr, int wc, int fr, int fq) const {
        const int row0 = u.pm * BM + wr * 64 + fr, col0 = u.pn * BM + wc * 32 + 8 * fq;
        float rsv[2][4];
#pragma unroll
        for (int ai = 0; ai < 2; ++ai)
#pragma unroll
            for (int m = 0; m < 4; ++m) rsv[ai][m] = RS ? ssq[row0 + ai * HALF + m * 16] : 0.f;
#pragma unroll
        for (int ai = 0; ai < 2; ++ai)
#pragma unroll
            for (int m = 0; m < 4; ++m) { const int row = row0 + ai * HALF + m * 16;
                bf16_t* rowp = (ACT == 1) ? O + ((size_t)(row >> 8) * (ldc >> 6) + (col0 >> 6)) * 16384 + (size_t)(row & 255) * 64 + (col0 & 63) : O + (size_t)row * ldc + col0;
                float rs = 1.f; if (RS) rs = 1.0f / sqrtf(rsv[ai][m] * (1.0f / 1024.0f) + RMS_EPS);
#pragma unroll
                for (int bj = 0; bj < 2; ++bj) { f32x4 v0 = acc[ai][bj][m][0], v1 = acc[ai][bj][m][1];
                    if (RS) { v0 = v0 * rs; v1 = v1 * rs; }
                    if (ACT == 1) {
#pragma unroll
                        for (int j = 0; j < 4; ++j) { const float a = v0[j] > 0.f ? v0[j] : 0.f, b = v1[j] > 0.f ? v1[j] : 0.f; v0[j] = a * a; v1[j] = b * b; } }
                    u32x4 w; w.x = cvt_pk_bf16(v0[0], v0[1]); w.y = cvt_pk_bf16(v0[2], v0[3]); w.z = cvt_pk_bf16(v1[0], v1[1]); w.w = cvt_pk_bf16(v1[2], v1[3]);
                    *(u32x4*)(rowp + (ACT == 1 ? bj * 2 * 16384 : bj * HALF)) = w; } }
    }
};
template <int MODE> struct EpiResid {
    static constexpr bool PERM = true, AFTER_DRAIN = false;
    const float* basef; bf16_t* hb; float* ssq; float* out; const float* gfin; unsigned* cnt;
    static __device__ __forceinline__ void unpk(const u32x4 w, f32x4& lo, f32x4& hi) {
        lo = (f32x4){__builtin_bit_cast(float, w.x << 16), __builtin_bit_cast(float, w.x & 0xffff0000u), __builtin_bit_cast(float, w.y << 16), __builtin_bit_cast(float, w.y & 0xffff0000u)};
        hi = (f32x4){__builtin_bit_cast(float, w.z << 16), __builtin_bit_cast(float, w.z & 0xffff0000u), __builtin_bit_cast(float, w.w << 16), __builtin_bit_cast(float, w.w & 0xffff0000u)}; }
    __device__ __forceinline__ void operator()(f32x4 (&acc)[2][2][4][2], const Unit& u, int wr, int wc, int fr, int fq) const {
        const int row0 = u.pm * BM + wr * 64 + fr, col0 = u.pn * BM + wc * 32 + 8 * fq;
#pragma unroll
        for (int ai = 0; ai < 2; ++ai) {
            u32x4 bs[4][2];
#pragma unroll
            for (int m = 0; m < 4; ++m)
#pragma unroll
                for (int bj = 0; bj < 2; ++bj) { const size_t o2 = (size_t)(row0 + ai * HALF + m * 16) * 1024 + col0 + bj * HALF;
                    if (MODE == 0) bs[m][bj] = __builtin_nontemporal_load((const u32x4*)((const bf16_t*)basef + o2));
                    else bs[m][bj] = *(const u32x4*)(hb + o2); }
#pragma unroll
            for (int m = 0; m < 4; ++m) { const int row = row0 + ai * HALF + m * 16; const size_t off = (size_t)row * 1024 + col0; float ss = 0.f;
#pragma unroll
                for (int bj = 0; bj < 2; ++bj) { f32x4 b0, b1; unpk(bs[m][bj], b0, b1);
                    const f32x4 o0 = b0 + acc[ai][bj][m][0], o1 = b1 + acc[ai][bj][m][1];
                    ss += ((o0[0] * o0[0] + o0[1] * o0[1]) + (o0[2] * o0[2] + o0[3] * o0[3])) + ((o1[0] * o1[0] + o1[1] * o1[1]) + (o1[2] * o1[2] + o1[3] * o1[3]));
                    if (MODE == 2) { acc[ai][bj][m][0] = o0; acc[ai][bj][m][1] = o1; }
                    else { u32x4 w; w.x = cvt_pk_bf16(o0[0], o0[1]); w.y = cvt_pk_bf16(o0[2], o0[3]); w.z = cvt_pk_bf16(o1[0], o1[1]); w.w = cvt_pk_bf16(o1[2], o1[3]); *(u32x4*)(hb + off + bj * HALF) = w; } }
                ss += __shfl_xor(ss, 16); ss += __shfl_xor(ss, 32); if (fq == 0) atomicAdd(ssq + row, ss); }
            asm volatile("" ::: "memory"); }
        if (MODE == 2) {
            asm volatile("s_waitcnt vmcnt(0)" ::: "memory");
            unsigned* c = cnt + 64 * u.pm;
            if (fr == 0 && fq == 0) __hip_atomic_fetch_add(c, 1u, __ATOMIC_RELAXED, __HIP_MEMORY_SCOPE_AGENT);
            unsigned spins = 0;
            while (__hip_atomic_load(c, __ATOMIC_RELAXED, __HIP_MEMORY_SCOPE_AGENT) < 32u) { __builtin_amdgcn_s_sleep(2); if (++spins > (1u << 22)) break; }
            asm volatile("" ::: "memory");
            f32x4 gv[2][2];
#pragma unroll
            for (int bj = 0; bj < 2; ++bj)
#pragma unroll
                for (int n = 0; n < 2; ++n) gv[bj][n] = *(const f32x4*)(gfin + col0 + bj * HALF + n * 4);
            float sv[2][4];
#pragma unroll
            for (int ai = 0; ai < 2; ++ai)
#pragma unroll
                for (int m = 0; m < 4; ++m) sv[ai][m] = __hip_atomic_load(ssq + row0 + ai * HALF + m * 16, __ATOMIC_RELAXED, __HIP_MEMORY_SCOPE_AGENT);
#pragma unroll
            for (int ai = 0; ai < 2; ++ai)
#pragma unroll
                for (int m = 0; m < 4; ++m) { const float rs = 1.0f / sqrtf(sv[ai][m] * (1.0f / 1024.0f) + RMS_EPS); const size_t off = (size_t)(row0 + ai * HALF + m * 16) * 1024 + col0;
#pragma unroll
                    for (int bj = 0; bj < 2; ++bj)
#pragma unroll
                        for (int n = 0; n < 2; ++n) *(f32x4*)(out + off + bj * HALF + n * 4) = acc[ai][bj][m][n] * rs * gv[bj][n]; }
        }
    }
};
struct EpiSoftmax {
    static constexpr bool PERM = true, AFTER_DRAIN = true;
    bf16_t* P; float scale_log2e;
    __device__ __forceinline__ void fused(f32x4 (&acc)[2][2][4][2], const Unit& u, int wr, int wc, int fr, int fq, PG8_LAS unsigned char* lds, int wid, int lane) const {
        PG8_LAS float* RM = (PG8_LAS float*)lds;
        PG8_LAS float* RSM = (PG8_LAS float*)(lds + 4096);
#pragma unroll
        for (int ai = 0; ai < 2; ++ai)
#pragma unroll
            for (int m = 0; m < 4; ++m) { float mx = -3.0e38f;
#pragma unroll
                for (int bj = 0; bj < 2; ++bj)
#pragma unroll
                    for (int n = 0; n < 2; ++n) { const f32x4 x = acc[ai][bj][m][n]; mx = fmaxf(mx, fmaxf(fmaxf(x[0], x[1]), fmaxf(x[2], x[3]))); }
                mx = fmaxf(mx, __shfl_xor(mx, 16)); mx = fmaxf(mx, __shfl_xor(mx, 32));
                if (fq == 0) RM[(ai * HALF + wr * 64 + m * 16 + fr) * 4 + wc] = mx; }
        asm volatile("s_waitcnt lgkmcnt(0)" ::: "memory"); __builtin_amdgcn_s_barrier(); asm volatile("" ::: "memory");
#pragma unroll
        for (int ai = 0; ai < 2; ++ai)
#pragma unroll
            for (int m = 0; m < 4; ++m) { const int r = ai * HALF + wr * 64 + m * 16 + fr; const f32x4 m4 = *(const PG8_LAS f32x4*)(RM + r * 4);
                const float gm = fmaxf(fmaxf(m4[0], m4[1]), fmaxf(m4[2], m4[3])); float s = 0.f;
#pragma unroll
                for (int bj = 0; bj < 2; ++bj)
#pragma unroll
                    for (int n = 0; n < 2; ++n) { f32x4 x = acc[ai][bj][m][n];
#pragma unroll
                        for (int j = 0; j < 4; ++j) { x[j] = __builtin_amdgcn_exp2f((x[j] - gm) * scale_log2e); s += x[j]; }
                        acc[ai][bj][m][n] = x; }
                s += __shfl_xor(s, 16); s += __shfl_xor(s, 32);
                if (fq == 0) RSM[r * 4 + wc] = s; }
        asm volatile("s_waitcnt lgkmcnt(0)" ::: "memory"); __builtin_amdgcn_s_barrier(); asm volatile("" ::: "memory");
        const int col0 = wc * 32 + 8 * fq;
#pragma unroll
        for (int ai = 0; ai < 2; ++ai)
#pragma unroll
            for (int m = 0; m < 4; ++m) { const int r = ai * HALF + wr * 64 + m * 16 + fr; const f32x4 s4 = *(const PG8_LAS f32x4*)(RSM + r * 4);
                const float inv = 1.0f / ((s4[0] + s4[1]) + (s4[2] + s4[3])); bf16_t* rowp = P + (size_t)r * 256 + col0;
#pragma unroll
                for (int bj = 0; bj < 2; ++bj) { const f32x4 v0 = acc[ai][bj][m][0] * inv, v1 = acc[ai][bj][m][1] * inv;
                    u32x4 w; w.x = cvt_pk_bf16(v0[0], v0[1]); w.y = cvt_pk_bf16(v0[2], v0[3]); w.z = cvt_pk_bf16(v1[0], v1[1]); w.w = cvt_pk_bf16(v1[2], v1[3]);
                    *(u32x4*)(rowp + bj * HALF) = w; } }
    }
};

struct EpiSoftmaxS {
    static constexpr bool PERM = true, AFTER_DRAIN = false;
    bf16_t* P; float scale_log2e; PG8_LAS unsigned char* tab;
    __device__ __forceinline__ void operator()(f32x4 (&acc)[2][2][4][2], const Unit& u, int wr, int wc, int fr, int fq) const {
        EpiSoftmax E{P + (size_t)u.id * 65536, scale_log2e};
        E.fused(acc, u, wr, wc, fr, fq, tab, 0, 0);
    }
};

template <class Epi, class Sched, bool ALIGN_EPI = false, bool SP2 = false>
__device__ __forceinline__ void gemm_phase(PG8_LAS unsigned char* lds, const Gemm g, const Sched& S, const Epi& E) {
    int tid_ = threadIdx.x; asm volatile("" : "+v"(tid_));
    const int tid = tid_, wid = __builtin_amdgcn_readfirstlane(tid >> 6), lane = tid & 63, wr = wid >> 2, wc = wid & 3, fr = lane & 15, fq = lane >> 4;
    const int K = g.K, nt = K / BK;
    unsigned voffA[2], voffB[2];
#pragma unroll
    for (int i = 0; i < 2; ++i) { int R, C; stage_rc(tid * 16 + i * 8192, R, C); const int Rb = Epi::PERM ? ((R & ~31) + perm32(R & 31)) : R;
        voffA[i] = (unsigned)(R * g.lda + C) * 2u; voffB[i] = (unsigned)(Rb * g.ldb + C) * 2u; }
    const size_t kstep = (size_t)(BK * 2);
    const size_t hstepA = (size_t)HALF * g.lda * 2, hstepB = (size_t)HALF * g.ldb * 2;
    const size_t tstepA = g.atstep ? g.atstep : 2 * hstepA, tstepB = 2 * hstepB;
    const size_t kstepA = g.akstep ? g.akstep : kstep;
    const unsigned ldsw = (unsigned)wid * 1024u;
    const int aoff = lds_byte(wr * 64 + fr, fq * 8), boff = lds_byte(wc * 32 + fr, fq * 8);
#define PG8_SA(b, h) (((b) * 2 + (h)) * HTB)
#define PG8_SB(b, h) ((4 + (b) * 2 + (h)) * HTB)
#define PG8_STAGE(bufoff, gbase, voff) do { _Pragma("unroll") for (int _i = 0; _i < 2; ++_i) \
        __builtin_amdgcn_global_load_lds((const unsigned*)((const char*)(gbase) + (voff)[_i]), (PG8_LAS unsigned*)(lds + (bufoff) + ldsw + _i * 8192), 16, 0, 0); } while (0)
#define PG8_LDA(dst, b, h) do { _Pragma("unroll") for (int m = 0; m < 4; ++m) _Pragma("unroll") for (int k = 0; k < 2; ++k) dst[m][k] = *(const PG8_LAS bf16x8*)(lds + PG8_SA(b, h) + aoff + m * 2048 + k * 1024); } while (0)
#define PG8_LDB(dst, b, h) do { _Pragma("unroll") for (int n = 0; n < 2; ++n) _Pragma("unroll") for (int k = 0; k < 2; ++k) dst[n][k] = *(const PG8_LAS bf16x8*)(lds + PG8_SB(b, h) + boff + n * 2048 + k * 1024); } while (0)
#define PG8_MMA(ai, bj, At, Bt) do { __builtin_amdgcn_s_setprio(1); _Pragma("unroll") for (int m = 0; m < 4; ++m) _Pragma("unroll") for (int n = 0; n < 2; ++n) _Pragma("unroll") for (int k = 0; k < 2; ++k) \
        acc[ai][bj][m][n] = __builtin_amdgcn_mfma_f32_16x16x32_bf16(Bt[n][k], At[m][k], acc[ai][bj][m][n], 0, 0, 0); __builtin_amdgcn_s_setprio(0); } while (0)
#define PG8_WAIT_V(n) asm volatile("s_waitcnt vmcnt(" #n ")" ::: "memory")
#define PG8_WAIT_L(n) asm volatile("s_waitcnt lgkmcnt(" #n ")" ::: "memory")
#define PG8_BAR __builtin_amdgcn_s_barrier()
#define PG8_SCHED __builtin_amdgcn_sched_barrier(0)
    Unit cur, nxt; int ui = 0;
    if (!S.next(0, cur)) return;
    f32x4 acc[2][2][4][2];
#pragma unroll
    for (int a = 0; a < 2; ++a)
#pragma unroll
        for (int b = 0; b < 2; ++b)
#pragma unroll
            for (int m = 0; m < 4; ++m)
#pragma unroll
                for (int n = 0; n < 2; ++n) acc[a][b][m][n] = (f32x4){0.f, 0.f, 0.f, 0.f};
    bf16x8 At[4][2], B0[2][2], B1[2][2];
    const char* cA = (const char*)g.A + (size_t)cur.pm * tstepA + cur.ao; const char* cB = (const char*)g.Bt + (size_t)cur.pn * tstepB + cur.bo;
    S.a_ready(cur);
    if constexpr (SP2) {
        PG8_STAGE(PG8_SB(0, 0), cB, voffB); PG8_STAGE(PG8_SB(0, 1), cB + hstepB, voffB); PG8_STAGE(PG8_SA(0, 0), cA, voffA); PG8_STAGE(PG8_SA(0, 1), cA + hstepA, voffA);
        if (wr == 1) PG8_BAR;
        PG8_WAIT_V(2); PG8_BAR;
        PG8_STAGE(PG8_SB(1, 0), cB + kstep, voffB); PG8_STAGE(PG8_SA(1, 0), cA + kstepA, voffA); PG8_STAGE(PG8_SB(1, 1), cB + hstepB + kstep, voffB);
        PG8_WAIT_V(6); PG8_BAR;
    } else {
        PG8_STAGE(PG8_SB(0, 0), cB, voffB); PG8_STAGE(PG8_SA(0, 0), cA, voffA); PG8_STAGE(PG8_SB(0, 1), cB + hstepB, voffB); PG8_STAGE(PG8_SA(0, 1), cA + hstepA, voffA);
        if (wr == 1) PG8_BAR;
        PG8_WAIT_V(4); PG8_BAR;
        PG8_STAGE(PG8_SB(1, 0), cB + kstep, voffB); PG8_STAGE(PG8_SA(1, 0), cA + kstepA, voffA); PG8_STAGE(PG8_SB(1, 1), cB + hstepB + kstep, voffB);
        PG8_WAIT_V(6); PG8_BAR;
    }
    for (;;) {
        const bool has_next = S.next(ui + 1, nxt);
        const char* nA = has_next ? (const char*)g.A + (size_t)nxt.pm * tstepA + nxt.ao : cA; const char* nB = has_next ? (const char*)g.Bt + (size_t)nxt.pn * tstepB + nxt.bo : cB;
#pragma unroll 1
        for (int t = 0; t < nt; t += 2) {
            const bool last = (t == nt - 2);
            const char* a1 = cA + (size_t)(t + 1) * kstepA;
            const char* a2 = last ? nA : cA + (size_t)(t + 2) * kstepA; const char* b2 = last ? nB : cB + (size_t)(t + 2) * kstep;
            const char* a3 = a2 + kstepA; const char* b3 = b2 + kstep;
            if (last && has_next) S.a_ready(nxt);
            if constexpr (SP2) {
            PG8_LDB(B0, 0, 0); PG8_LDB(B1, 0, 1); PG8_SCHED; PG8_LDA(At, 0, 0); PG8_STAGE(PG8_SA(1, 1), a1 + hstepA, voffA);
            PG8_WAIT_V(8); PG8_WAIT_L(0); PG8_BAR; PG8_MMA(0, 0, At, B0); PG8_MMA(0, 1, At, B1); PG8_BAR; PG8_SCHED;
            PG8_LDA(At, 0, 1); PG8_STAGE(PG8_SB(0, 0), b2, voffB); PG8_STAGE(PG8_SB(0, 1), b2 + hstepB, voffB); PG8_STAGE(PG8_SA(0, 0), a2, voffA);
            PG8_WAIT_V(8); PG8_WAIT_L(0); PG8_BAR; PG8_MMA(1, 0, At, B0); PG8_MMA(1, 1, At, B1); PG8_BAR; PG8_SCHED;
            PG8_LDB(B0, 1, 0); PG8_LDB(B1, 1, 1); PG8_SCHED; PG8_LDA(At, 1, 0); PG8_STAGE(PG8_SA(0, 1), a2 + hstepA, voffA);
            PG8_WAIT_V(8); PG8_WAIT_L(0); PG8_BAR; PG8_MMA(0, 0, At, B0); PG8_MMA(0, 1, At, B1); PG8_BAR; PG8_SCHED;
            PG8_LDA(At, 1, 1); PG8_STAGE(PG8_SB(1, 0), b3, voffB); PG8_STAGE(PG8_SB(1, 1), b3 + hstepB, voffB); PG8_STAGE(PG8_SA(1, 0), a3, voffA);
            PG8_WAIT_V(8); PG8_WAIT_L(0); PG8_BAR; PG8_MMA(1, 0, At, B0); PG8_MMA(1, 1, At, B1); PG8_BAR; PG8_SCHED;
            } else {
            PG8_LDB(B0, 0, 0); PG8_SCHED; PG8_LDA(At, 0, 0); PG8_STAGE(PG8_SA(1, 1), a1 + hstepA, voffA);
            PG8_WAIT_L(8); PG8_BAR; PG8_WAIT_L(0); PG8_MMA(0, 0, At, B0); PG8_BAR; PG8_SCHED;
            PG8_LDB(B1, 0, 1); PG8_STAGE(PG8_SB(0, 0), b2, voffB);
            PG8_BAR; PG8_WAIT_L(0); PG8_MMA(0, 1, At, B1); PG8_BAR;
            PG8_LDA(At, 0, 1); PG8_STAGE(PG8_SA(0, 0), a2, voffA);
            PG8_BAR; PG8_WAIT_L(0); PG8_MMA(1, 0, At, B0); PG8_BAR; PG8_SCHED;
            PG8_STAGE(PG8_SB(0, 1), b2 + hstepB, voffB);
            PG8_WAIT_V(6); PG8_BAR; PG8_MMA(1, 1, At, B1); PG8_BAR;
            PG8_LDB(B0, 1, 0); PG8_SCHED; PG8_LDA(At, 1, 0); PG8_STAGE(PG8_SA(0, 1), a2 + hstepA, voffA);
            PG8_WAIT_L(8); PG8_BAR; PG8_WAIT_L(0); PG8_MMA(0, 0, At, B0); PG8_BAR; PG8_SCHED;
            PG8_LDB(B1, 1, 1); PG8_STAGE(PG8_SB(1, 0), b3, voffB);
            PG8_BAR; PG8_WAIT_L(0); PG8_MMA(0, 1, At, B1); PG8_BAR;
            PG8_LDA(At, 1, 1); PG8_STAGE(PG8_SA(1, 0), a3, voffA);
            PG8_BAR; PG8_WAIT_L(0); PG8_MMA(1, 0, At, B0); PG8_BAR; PG8_SCHED;
            PG8_STAGE(PG8_SB(1, 1), b3 + hstepB, voffB);
            PG8_WAIT_V(6); PG8_BAR; PG8_MMA(1, 1, At, B1); PG8_BAR;
            }
        }
        if constexpr (ALIGN_EPI) { if (wr == 0) PG8_BAR; }
        if constexpr (!Epi::AFTER_DRAIN) { E(acc, cur, wr, wc, fr, fq); S.done(cur); }
        if (!has_next) break;
#pragma unroll
        for (int a = 0; a < 2; ++a)
#pragma unroll
            for (int b = 0; b < 2; ++b)
#pragma unroll
                for (int m = 0; m < 4; ++m)
#pragma unroll
                    for (int n = 0; n < 2; ++n) acc[a][b][m][n] = (f32x4){0.f, 0.f, 0.f, 0.f};
        cur = nxt; cA = nA; cB = nB; ++ui;
        if constexpr (ALIGN_EPI) { if (wr == 1) PG8_BAR; }
    }
    PG8_WAIT_V(0);
    if constexpr (!ALIGN_EPI) { if (wr == 0) PG8_BAR; }
    PG8_BAR;
    if constexpr (Epi::AFTER_DRAIN) { E.fused(acc, cur, wr, wc, fr, fq, lds, wid, lane); S.done(cur); }
#undef PG8_SA
#undef PG8_SB
#undef PG8_STAGE
#undef PG8_LDA
#undef PG8_LDB
#undef PG8_MMA
#undef PG8_WAIT_V
#undef PG8_WAIT_L
#undef PG8_BAR
#undef PG8_SCHED
}
}

constexpr int NWAVES = 8;
constexpr int N_LAUNCHES = MK_N_LAUNCHES;
constexpr int N_PHASES = 11;
constexpr int BATCH = 16, SEQ = 2048, D = 1024, M = BATCH * SEQ;
constexpr int NPROJ = 2560, INCOLS = 2568, MEML = 256, MROWS = BATCH * MEML, FF = 4096;
constexpr int DNW = 512, DNH = 4, DNHD = 128, CHUNK = 64;

constexpr size_t MiB = 1u << 20;
constexpr size_t WS_CTL = 0, CTL_ZERO_BYTES = 1 * MiB;
constexpr size_t WS_BA = 1 * MiB;
constexpr size_t WS_SSQ1 = 256 * 1024, WS_SSQ2 = 512 * 1024, WS_SSQ3 = 768 * 1024, WS_CNT3 = 896 * 1024;
constexpr size_t WS_WIN = 8 * MiB, WS_WOUT = 13 * MiB, WS_WQ = 15 * MiB, WS_WK = 17 * MiB, WS_WV = 19 * MiB, WS_WO = 21 * MiB, WS_WUP = 23 * MiB, WS_WDN = 31 * MiB;
constexpr size_t WS_MN = 40 * MiB, WS_KM = 48 * MiB, WS_VT = 56 * MiB;
constexpr size_t WS_A = 64 * MiB;
constexpr size_t WS_SSQ0 = 2 * MiB;
constexpr size_t WS_Y = 352 * MiB;
constexpr size_t WS_B = 128 * MiB;
constexpr size_t WS_C = 192 * MiB;
constexpr size_t WS_PS = 256 * MiB;
constexpr size_t WS_OR = 128 * MiB;
constexpr size_t WS_GWM = 352 * MiB, WS_GUT = 384 * MiB, WS_GQG = 416 * MiB, WS_GKD = 448 * MiB, WS_GAM = 480 * MiB, WS_GGL = 496 * MiB;
constexpr size_t WS_END = 497 * MiB;
constexpr int CW_BAR = 4096;

constexpr int RING_BYTES = 131072;
constexpr int LDS_BYTES = 147456;
constexpr int LDSCTL_OFF = LDS_BYTES - 512, MISC_OFF = LDSCTL_OFF + 320;

#define GAS __attribute__((address_space(1)))
#define LAS __attribute__((address_space(3)))
typedef unsigned short bf16;
typedef unsigned v4u __attribute__((ext_vector_type(4)));
typedef unsigned v2u __attribute__((ext_vector_type(2)));
typedef float f32x4 __attribute__((ext_vector_type(4)));
typedef GAS unsigned gu32;
#define LDS_WAIT() asm volatile("s_waitcnt lgkmcnt(0)" ::: "memory")
#define VM_WAIT() asm volatile("s_waitcnt vmcnt(0)" ::: "memory")
typedef float f32x2_t __attribute__((ext_vector_type(2)));
typedef __bf16 bf16x2_t __attribute__((ext_vector_type(2)));
__device__ __forceinline__ unsigned pk2(float lo, float hi) { const f32x2_t v = {lo, hi}; const bf16x2_t b = __builtin_convertvector(v, bf16x2_t); return __builtin_bit_cast(unsigned, b); }
__device__ __forceinline__ unsigned f2bf(float f) { return pk2(f, 0.f) & 0xffffu; }
__device__ __forceinline__ float bflo(unsigned w) { return __builtin_bit_cast(float, w << 16); }
__device__ __forceinline__ float bfhi(unsigned w) { return __builtin_bit_cast(float, w & 0xffff0000u); }
__device__ __forceinline__ void unpack8(const v4u w, float (&f)[8]) { f[0] = bflo(w.x); f[1] = bfhi(w.x); f[2] = bflo(w.y); f[3] = bfhi(w.y); f[4] = bflo(w.z); f[5] = bfhi(w.z); f[6] = bflo(w.w); f[7] = bfhi(w.w); }

#define XB_TMO      128
#define XB_XCNT(j)  (256  + 64 * (j))
#define XB_XSUB(j)  (1280 + 64 * (j))
#define XB_XGEN(j)  (2304 + 64 * (j))
#define XB_TOP      3328
#define XB_TOPGEN   3392
#define XCD_BAR_WORDS 3456
#define XB_SPIN_CAP (1u << 18)
__device__ __forceinline__ unsigned xb_ld(unsigned* p)              { return __hip_atomic_load(p, __ATOMIC_RELAXED, __HIP_MEMORY_SCOPE_AGENT); }
__device__ __forceinline__ unsigned xb_add(unsigned* p, unsigned v) { return __hip_atomic_fetch_add(p, v, __ATOMIC_RELAXED, __HIP_MEMORY_SCOPE_AGENT); }
__device__ __forceinline__ unsigned xb_xcc_id() { return (unsigned)__builtin_amdgcn_s_getreg((3 << 11) | 20) & 0xFu; }
#define XB_SPIN(cond, bar) do { unsigned _sp = 0; while (cond) { __builtin_amdgcn_s_sleep(1); \
    if ((++_sp & 255u) == 0u) { if (xb_ld(&(bar)[XB_TMO])) break; if (_sp > XB_SPIN_CAP) { atomicAdd(&(bar)[XB_TMO], 1u); break; } } } } while (0)
struct XcdBarrier { unsigned* bar; unsigned x; volatile LAS unsigned* st; };
__device__ __forceinline__ XcdBarrier xcd_barrier_post(unsigned* bar, volatile LAS unsigned* st) {
    XcdBarrier b; b.bar = bar; b.x = xb_xcc_id(); b.st = st;
    if (threadIdx.x == 0) (void)xb_add(&bar[XB_XCNT(b.x)], 1u);
    return b;
}
__device__ __forceinline__ void xcd_barrier_complete(unsigned* bar, unsigned x, unsigned& nloc, unsigned& nx) {
    const unsigned G = gridDim.x * gridDim.y * gridDim.z;
    unsigned sum, cnt, mine, sp = 0u;
    for (;;) {
        sum = 0u; cnt = 0u; mine = 0u;
#pragma unroll
        for (unsigned j = 0; j < 16; ++j) { const unsigned c = xb_ld(&bar[XB_XCNT(j)]); sum += c; cnt += (c > 0u) ? 1u : 0u; mine = (j == x) ? c : mine; }
        if (sum == G) break;
        __builtin_amdgcn_s_sleep(1);
        if ((++sp & 255u) == 0u) { if (xb_ld(&bar[XB_TMO])) break; if (sp > XB_SPIN_CAP) { atomicAdd(&bar[XB_TMO], 1u); break; } }
    }
    nloc = mine > 0u ? mine : 1u; nx = cnt > 0u ? cnt : 1u;
}
__device__ __forceinline__ void xcd_barrier(const XcdBarrier& b) {
    asm volatile("s_waitcnt vmcnt(0)" ::: "memory");
    __syncthreads();
    if (threadIdx.x == 0) {
        unsigned* bar = b.bar;
        __builtin_amdgcn_s_waitcnt(0);
        unsigned nloc = b.st[0], nx = b.st[1];
        if (nloc == 0u) { xcd_barrier_complete(bar, b.x, nloc, nx); b.st[0] = nloc; b.st[1] = nx; }
        const unsigned old = xb_add(&bar[XB_XSUB(b.x)], 1u);
        const unsigned gen = old / nloc;
        if (old + 1u == (gen + 1u) * nloc) {
            __builtin_amdgcn_fence(__ATOMIC_RELEASE, "agent");
            asm volatile("s_waitcnt vmcnt(0)" ::: "memory");
            const unsigned og = xb_add(&bar[XB_TOP], 1u);
            const unsigned tg = og / nx;
            if (og + 1u == (tg + 1u) * nx) xb_add(&bar[XB_TOPGEN], 1u);
            else XB_SPIN(xb_ld(&bar[XB_TOPGEN]) == tg, bar);
            __builtin_amdgcn_fence(__ATOMIC_ACQUIRE, "agent");
            xb_add(&bar[XB_XGEN(b.x)], 1u);
            asm volatile("s_waitcnt vmcnt(0)" ::: "memory");
        } else {
            XB_SPIN(xb_ld(&bar[XB_XGEN(b.x)]) == gen, bar);
            __builtin_amdgcn_fence(__ATOMIC_ACQUIRE, "agent");
            asm volatile("s_waitcnt vmcnt(0)" ::: "memory");
        }
    }
    __syncthreads();
}


__device__ __forceinline__ float dppf(float v, const int ctrl_sel) {
    const int x = __builtin_bit_cast(int, v); int r;
    if (ctrl_sel == 0) r = __builtin_amdgcn_update_dpp(0, x, 0xB1, 0xF, 0xF, true);
    else if (ctrl_sel == 1) r = __builtin_amdgcn_update_dpp(0, x, 0x4E, 0xF, 0xF, true);
    else if (ctrl_sel == 2) r = __builtin_amdgcn_update_dpp(0, x, 0x141, 0xF, 0xF, true);
    else r = __builtin_amdgcn_update_dpp(0, x, 0x140, 0xF, 0xF, true);
    return __builtin_bit_cast(float, r);
}
__device__ __forceinline__ float row16_sum(float v) {
    v += dppf(v, 0); v += dppf(v, 1); v += dppf(v, 2); v += dppf(v, 3); return v;
}
__device__ __forceinline__ float wave_sum(float v) {
    v = row16_sum(v);
    const int x = __builtin_bit_cast(int, v);
    const float a = __builtin_bit_cast(float, __builtin_amdgcn_readlane(x, 0)), b = __builtin_bit_cast(float, __builtin_amdgcn_readlane(x, 16));
    const float c = __builtin_bit_cast(float, __builtin_amdgcn_readlane(x, 32)), d = __builtin_bit_cast(float, __builtin_amdgcn_readlane(x, 48));
    return (a + b) + (c + d);
}
__device__ __forceinline__ float silu_f(float x) { return x * __builtin_amdgcn_rcpf(1.0f + __expf(-x)); }

#define PHASE_TID() int tid_ = threadIdx.x; asm volatile("" : "+v"(tid_)); const int tid = tid_, lane = tid & 63, wave = __builtin_amdgcn_readfirstlane(tid >> 6); (void)lane; (void)wave
struct Ctx {
    LAS unsigned char* lds;
    int vcu, G;
    const float *x, *mem, *g_mix, *w_in, *w_pool, *pool_scale, *conv_w, *a_log, *dt_bias, *g_dn, *w_out, *g_xa, *g_mem, *w_xq, *w_xk, *w_xv, *w_xo, *g_mlp, *w_up, *w_down, *g_fin;
    float* out; unsigned char* ws;
};

__device__ __forceinline__ void transpose_item(const float* W, int ldw, int nblk, const float* kscale, bf16* WT, int ldt, int koff, LAS float* scr, int item, int lane) {
    const int kb = item / nblk, nb = item % nblk, k0 = 64 * kb, n0 = 32 * nb;
    f32x4 wv[8];
#pragma unroll
    for (int i = 0; i < 8; ++i) wv[i] = __builtin_nontemporal_load((const f32x4*)(W + (size_t)(k0 + (lane >> 3) + 8 * i) * ldw + n0 + 4 * (lane & 7)));
#pragma unroll
    for (int i = 0; i < 8; ++i) { const int kk = (lane >> 3) + 8 * i; f32x4 v = wv[i]; if (kscale) v = v * kscale[k0 + kk];
        LAS float* d = scr + kk * 33 + 4 * (lane & 7); d[0] = v[0]; d[1] = v[1]; d[2] = v[2]; d[3] = v[3]; }
    LDS_WAIT(); asm volatile("" ::: "memory");
    const int c = lane & 7;
#pragma unroll
    for (int j = 0; j < 4; ++j) { const int n = (lane >> 3) + 8 * j; const LAS float* s = scr + (8 * c) * 33 + n;
        v4u o; o.x = pk2(s[0 * 33], s[1 * 33]); o.y = pk2(s[2 * 33], s[3 * 33]); o.z = pk2(s[4 * 33], s[5 * 33]); o.w = pk2(s[6 * 33], s[7 * 33]);
        *(GAS v4u*)(WT + (size_t)(n0 + n) * ldt + koff + k0 + 8 * c) = o; }
    LDS_WAIT(); asm volatile("" ::: "memory");
}

__device__ __forceinline__ void late_weight_copies(const Ctx& F, int wgi, int nwg) {
    PHASE_TID();
    LAS float* scr = (LAS float*)(F.lds + wave * 16384);
    bf16* WQ = (bf16*)(F.ws + WS_WQ); bf16* WO = (bf16*)(F.ws + WS_WO); bf16* WUP = (bf16*)(F.ws + WS_WUP); bf16* WDN = (bf16*)(F.ws + WS_WDN);
    constexpr int I_SQ = 16 * 32, I_UP = 16 * 128, I_DN = 64 * 32, NITEMS = 2 * I_SQ + I_UP + I_DN;
    for (int it = wgi * NWAVES + wave; it < NITEMS; it += nwg * NWAVES) {
        int r = it;
        if (r < I_SQ) { transpose_item(F.w_xq, 1024, 32, F.g_xa, WQ, 1024, 0, scr, r, lane); continue; } r -= I_SQ;
        if (r < I_SQ) { transpose_item(F.w_xo, 1024, 32, nullptr, WO, 1024, 0, scr, r, lane); continue; } r -= I_SQ;
        if (r < I_UP) { transpose_item(F.w_up, 4096, 128, F.g_mlp, WUP, 1024, 0, scr, r, lane); continue; } r -= I_UP;
        transpose_item(F.w_down, 1024, 32, nullptr, WDN, 4096, 0, scr, r, lane);
    }
}

__device__ __forceinline__ void p0_prologue(const Ctx& F) {
    PHASE_TID();
    LAS float* scr = (LAS float*)(F.lds + wave * 16384);
    const int gw = F.vcu * NWAVES + wave, NGW = F.G * NWAVES;
    bf16* WIN = (bf16*)(F.ws + WS_WIN); bf16* WOUT = (bf16*)(F.ws + WS_WOUT); bf16* WK = (bf16*)(F.ws + WS_WK);
    bf16* WV = (bf16*)(F.ws + WS_WV);
    constexpr int I_IN = 16 * 80, I_OUT = 8 * 32, I_SQ = 16 * 32;
    constexpr int NITEMS = I_IN + I_OUT + 2 * I_SQ;
    for (int it = gw; it < NITEMS; it += NGW) {
        int r = it;
        if (r < I_IN) { transpose_item(F.w_in, INCOLS, 80, F.g_mix, WIN, 1024, 0, scr, r, lane); continue; } r -= I_IN;
        if (r < I_OUT) { transpose_item(F.w_out + (size_t)512 * 1024, 1024, 32, nullptr, WOUT, 1024, 512, scr, r, lane); continue; } r -= I_OUT;
        if (r < I_SQ) { transpose_item(F.w_xk, 1024, 32, nullptr, WK, 1024, 0, scr, r, lane); continue; } r -= I_SQ;
        transpose_item(F.w_xv, 1024, 32, nullptr, WV, 1024, 0, scr, r, lane);
    }
    for (int it = (F.vcu * NWAVES * 64) + tid; it < 1024 * 64; it += F.G * NWAVES * 64) {
        const int n = it & 1023, k8 = it >> 10, g = k8 >> 4, c0 = (k8 & 15) * 8;
        float acc[8];
#pragma unroll
        for (int j = 0; j < 8; ++j) acc[j] = 0.f;
        const float* wp = F.w_pool + (size_t)(g * 128 + c0) * 128;
        for (int d = 0; d < 128; ++d) { const float wo = F.w_out[(size_t)(g * 128 + d) * 1024 + n] * F.pool_scale[g * 128 + d];
#pragma unroll
            for (int j = 0; j < 8; ++j) acc[j] += wp[j * 128 + d] * wo; }
        v4u o; o.x = pk2(acc[0], acc[1]); o.y = pk2(acc[2], acc[3]); o.z = pk2(acc[4], acc[5]); o.w = pk2(acc[6], acc[7]);
        *(GAS v4u*)(WOUT + (size_t)n * 1024 + g * 128 + c0) = o;
    }
    {
        float wba[16][8];
#pragma unroll
        for (int j = 0; j < 4; ++j)
#pragma unroll
            for (int i = 0; i < 4; ++i) { const int k = 4 * lane + 256 * j + i; const f32x4* p = (const f32x4*)(F.w_in + (size_t)k * INCOLS + NPROJ); const f32x4 a = p[0], b = p[1];
                wba[j * 4 + i][0] = a[0]; wba[j * 4 + i][1] = a[1]; wba[j * 4 + i][2] = a[2]; wba[j * 4 + i][3] = a[3]; wba[j * 4 + i][4] = b[0]; wba[j * 4 + i][5] = b[1]; wba[j * 4 + i][6] = b[2]; wba[j * 4 + i][7] = b[3]; }
        f32x4 gv[4];
#pragma unroll
        for (int j = 0; j < 4; ++j) gv[j] = ((const f32x4*)F.g_mix)[lane + 64 * j];
        bf16* XN = (bf16*)(F.ws + WS_A); float* BA = (float*)(F.ws + WS_BA);
        for (int m = gw; m < M; m += NGW) {
            const GAS f32x4* xr = (const GAS f32x4*)(F.x + (size_t)m * D) + lane;
            f32x4 v[4]; float s = 0.f;
#pragma unroll
            for (int j = 0; j < 4; ++j) { v[j] = __builtin_nontemporal_load(xr + 64 * j); s += (v[j][0] * v[j][0] + v[j][1] * v[j][1]) + (v[j][2] * v[j][2] + v[j][3] * v[j][3]); }
            const float ssx = wave_sum(s);
            const float rs = 1.0f / sqrtf(ssx * (1.0f / D) + pg8::RMS_EPS);
            GAS unsigned long long* o8 = (GAS unsigned long long*)(XN + (size_t)m * D) + lane;
            float dsum[8];
#pragma unroll
            for (int c = 0; c < 8; ++c) dsum[c] = 0.f;
#pragma unroll
            for (int j = 0; j < 4; ++j) {
                o8[64 * j] = (unsigned long long)pk2(v[j][0], v[j][1]) | ((unsigned long long)pk2(v[j][2], v[j][3]) << 32);
                v[j] = v[j] * rs * gv[j];
#pragma unroll
                for (int i = 0; i < 4; ++i)
#pragma unroll
                    for (int c = 0; c < 8; ++c) dsum[c] += v[j][i] * wba[j * 4 + i][c]; }
#pragma unroll
            for (int c = 0; c < 8; ++c) dsum[c] = wave_sum(dsum[c]);
            if (lane == 0) { ((float*)(F.ws + WS_SSQ0))[m] = ssx; *(GAS f32x4*)(BA + (size_t)m * 8) = (f32x4){dsum[0], dsum[1], dsum[2], dsum[3]}; *(GAS f32x4*)(BA + (size_t)m * 8 + 4) = (f32x4){dsum[4], dsum[5], dsum[6], dsum[7]}; }
        }
    }
    {
        f32x4 gv[4];
#pragma unroll
        for (int j = 0; j < 4; ++j) gv[j] = ((const f32x4*)F.g_mem)[lane + 64 * j];
        bf16* MN = (bf16*)(F.ws + WS_MN);
        for (int m = gw; m < MROWS; m += NGW) {
            const GAS f32x4* xr = (const GAS f32x4*)(F.mem + (size_t)m * D) + lane;
            f32x4 v[4]; float s = 0.f;
#pragma unroll
            for (int j = 0; j < 4; ++j) { v[j] = __builtin_nontemporal_load(xr + 64 * j); s += (v[j][0] * v[j][0] + v[j][1] * v[j][1]) + (v[j][2] * v[j][2] + v[j][3] * v[j][3]); }
            const float rs = 1.0f / sqrtf(wave_sum(s) * (1.0f / D) + pg8::RMS_EPS);
            GAS unsigned long long* o8 = (GAS unsigned long long*)(MN + (size_t)m * D) + lane;
#pragma unroll
            for (int j = 0; j < 4; ++j) { v[j] = v[j] * rs * gv[j]; o8[64 * j] = (unsigned long long)pk2(v[j][0], v[j][1]) | ((unsigned long long)pk2(v[j][2], v[j][3]) << 32); }
        }
    }
}

typedef short bf16x8v __attribute__((ext_vector_type(8)));
__device__ __forceinline__ f32x4 mfma16(bf16x8v x, bf16x8v y, f32x4 c) { return __builtin_amdgcn_mfma_f32_16x16x32_bf16(x, y, c, 0, 0, 0); }
constexpr int GA_QB = 0, GA_KB = 17408, GA_VB = 34816, GA_LM = 51200, GA_GC = 67584, GA_BT = GA_GC + 256, GA_EG = GA_BT + 256, GA_ED = GA_EG + 256;
constexpr int GA_SZ = GA_ED + 256;
constexpr int GQS = 136;
__device__ __forceinline__ v4u pack8(const float (&f)[8]) { v4u o; o.x = pk2(f[0], f[1]); o.y = pk2(f[2], f[3]); o.z = pk2(f[4], f[5]); o.w = pk2(f[6], f[7]); return o; }
__device__ __forceinline__ float bf2f(unsigned short h) { return __builtin_bit_cast(float, (unsigned)h << 16); }

template <int J, int H> struct SubHalf { static constexpr int G0 = (J + 1) >> 2, GLO = H ? (G0 > 8 ? G0 : 8) : (G0 < 8 ? G0 : 8), GHI = H ? 16 : 8, N = GHI - GLO; };
template <int J, int H> __device__ __forceinline__ void subst_load(f32x4 (&l)[8], const LAS float* LTv) {
    if constexpr (J < 63) {
        using P = SubHalf<J, H>;
#pragma unroll
        for (int g = 0; g < P::N; ++g) l[g] = *(const LAS f32x4*)(LTv + J * 64 + 4 * (P::GLO + g));
    }
}
typedef float f32x2v_ __attribute__((ext_vector_type(2)));
template <int J, int H> __device__ __forceinline__ void subst_fma(f32x2v_ (&R)[64], const f32x4 (&l)[8], const f32x2v_ x) {
    using P = SubHalf<J, H>;
#pragma unroll
    for (int g = 0; g < P::N; ++g)
#pragma unroll
        for (int e = 0; e < 4; ++e) { const int i = 4 * (P::GLO + g) + e; if (i > J) { const float lv = l[g][e]; R[i] = __builtin_elementwise_fma((f32x2v_){-lv, -lv}, x, R[i]); } }
}
template <int J> __device__ __forceinline__ void subst_step(f32x2v_ (&R)[64], f32x4 (&la)[8], f32x4 (&lb)[8], const LAS float* LTv) {
    const f32x2v_ x = R[J];
    subst_load<J, 1>(lb, LTv);
    subst_fma<J, 0>(R, la, x);
    __builtin_amdgcn_sched_barrier(0);
    subst_load<J + 1, 0>(la, LTv);
    subst_fma<J, 1>(R, lb, x);
    __builtin_amdgcn_sched_barrier(0);
}
template <int... Js> __device__ __forceinline__ void subst_all(f32x2v_ (&R)[64], f32x4 (&la)[8], f32x4 (&lb)[8], const LAS float* LTv, std::integer_sequence<int, Js...>) {
    (subst_step<Js>(R, la, lb, LTv), ...);
}

constexpr int GA_TB = 2 * GA_SZ;
static_assert(GA_TB + 4096 <= LDSCTL_OFF, "P2a LDS map");
__device__ __forceinline__ void p2a_tables(const Ctx& F, int pr, int tboff, int t128, const float* BA, float* GL) {
    if (t128 >= 0 && t128 < 128) {
        const int ch0 = 2 * pr, bh = ch0 >> 5, chunk0 = ch0 & 31, b = bh >> 2, h = bh & 3, p = t128 >> 6, t = t128 & 63;
        const size_t row0 = (size_t)b * SEQ + chunk0 * CHUNK;
        LAS float* gcs = (LAS float*)(F.lds + tboff + p * 1024);
        const float bb = BA[(row0 + t128) * 8 + h], aa = BA[(row0 + t128) * 8 + 4 + h] + F.dt_bias[h];
        const float sp = aa > 20.f ? aa : __logf(1.0f + __expf(aa));
        float gc = -__expf(F.a_log[h]) * sp;
#pragma unroll
        for (int o = 1; o < 64; o <<= 1) { const float tt = __builtin_bit_cast(float, __builtin_amdgcn_ds_bpermute(((t - o) & 63) << 2, __builtin_bit_cast(int, gc))); if (t >= o) gc += tt; }
        const float g63 = __builtin_bit_cast(float, __builtin_amdgcn_readlane(__builtin_bit_cast(int, gc), 63));
        gcs[t] = gc; gcs[64 + t] = 1.0f / (1.0f + __expf(-bb)); gcs[128 + t] = __expf(gc); gcs[192 + t] = __expf(g63 - gc);
        if (t == 63) GL[ch0 + p] = __expf(gc);
    }
}

#define P2A_LBAR() do { asm volatile("s_waitcnt lgkmcnt(0)" ::: "memory"); __builtin_amdgcn_s_barrier(); asm volatile("" ::: "memory"); } while (0)
__device__ __forceinline__ void p2a_prep_block(const Ctx& F, const int pr, const int tboff, const int tbk, const int cg, const bf16* PROJ, bf16* QG) {
    const int ch0 = 2 * pr, bh = ch0 >> 5, chunk0 = ch0 & 31, b = bh >> 2, h = bh & 3;
    const size_t row0 = (size_t)b * SEQ + chunk0 * CHUNK;
    const int p = tbk >> 4, tl0 = (4 * tbk) & 63, tok0 = chunk0 * CHUNK + 4 * tbk; const size_t rowb = row0 + 4 * tbk;
    LAS bf16* Qb = (LAS bf16*)(F.lds + p * GA_SZ + GA_QB); LAS bf16* Kb = (LAS bf16*)(F.lds + p * GA_SZ + GA_KB); LAS bf16* Vb = (LAS bf16*)(F.lds + p * GA_SZ + GA_VB);
    const LAS float* egs = (const LAS float*)(F.lds + tboff + p * 1024 + 512);
    v4u raw[3][7];
#pragma unroll
    for (int ty = 0; ty < 3; ++ty)
#pragma unroll
        for (int r = 0; r < 7; ++r) { const bool ok = tok0 - 3 + r >= 0; const size_t rr = ok ? rowb - 3 + r : rowb;
            v4u w = __builtin_nontemporal_load((const GAS v4u*)(PROJ + rr * NPROJ + 512 + 512 * ty + h * 128 + cg * 8));
            if (!ok) w = (v4u){0u, 0u, 0u, 0u};
            raw[ty][r] = w; }
    __builtin_amdgcn_sched_barrier(0);
    v4u qgp[4];
#pragma unroll
    for (int ty = 0; ty < 3; ++ty) {
        float wt[4][8], res[4][8];
#pragma unroll
        for (int i = 0; i < 4; ++i) { const f32x4* pw = (const f32x4*)(F.conv_w + (size_t)i * 1536 + 512 * ty + h * 128 + cg * 8); const f32x4 a0 = pw[0], a1 = pw[1];
#pragma unroll
            for (int e = 0; e < 4; ++e) { wt[i][e] = a0[e]; wt[i][4 + e] = a1[e]; } }
#pragma unroll
        for (int e = 0; e < 4; ++e)
#pragma unroll
            for (int c = 0; c < 8; ++c) res[e][c] = 0.f;
#pragma unroll
        for (int r = 0; r < 7; ++r) { float f[8]; unpack8(raw[ty][r], f);
#pragma unroll
            for (int e = 0; e < 4; ++e) { const int i = r - e; if (i >= 0 && i < 4) {
#pragma unroll
                    for (int c = 0; c < 8; ++c) res[e][c] += wt[i][c] * f[c]; } } }
#pragma unroll
        for (int e = 0; e < 4; ++e) { const int t = tl0 + e;
            float ss = 0.f;
#pragma unroll
            for (int c = 0; c < 8; ++c) { res[e][c] = silu_f(res[e][c]); ss += res[e][c] * res[e][c]; }
            if (ty == 0) { ss = row16_sum(ss); const float rq = (1.0f / sqrtf(ss + 1e-6f)) * 0.08838834764831845f, eg = egs[t]; float qg[8];
#pragma unroll
                for (int c = 0; c < 8; ++c) { res[e][c] *= rq; qg[c] = res[e][c] * eg; }
                *(LAS v4u*)(Qb + t * GQS + cg * 8) = pack8(res[e]); qgp[e] = pack8(qg); }
            else if (ty == 1) { ss = row16_sum(ss); const float rk = 1.0f / sqrtf(ss + 1e-6f);
#pragma unroll
                for (int c = 0; c < 8; ++c) res[e][c] *= rk;
                *(LAS v4u*)(Kb + t * GQS + cg * 8) = pack8(res[e]); }
            else *(LAS v4u*)(Vb + t * 128 + cg * 8) = pack8(res[e]);
        }
    }
#pragma unroll
    for (int e = 0; e < 4; ++e) *(GAS v4u*)(QG + (size_t)(ch0 + p) * 8192 + (tl0 + e) * 128 + cg * 8) = qgp[e];
}
__device__ __forceinline__ void p2a_tiles(const Ctx& F, const int pr, const int tboff, const int wave, const int r16, const int q4, bf16* AM) {
    const int ch0 = 2 * pr;
    for (int job = wave; job < 20; job += NWAVES) {
        const int p = job >= 10 ? 1 : 0, idx = job - 10 * p;
        const LAS bf16* Qb = (const LAS bf16*)(F.lds + p * GA_SZ + GA_QB); const LAS bf16* Kb = (const LAS bf16*)(F.lds + p * GA_SZ + GA_KB);
        LAS float* LT = (LAS float*)(F.lds + p * GA_SZ + GA_LM); const LAS float* gcs = (const LAS float*)(F.lds + tboff + p * 1024); const LAS float* bts = gcs + 64;
        const int ti = idx < 1 ? 0 : (idx < 3 ? 1 : (idx < 6 ? 2 : 3)), tj = idx - (ti * (ti + 1)) / 2;
        f32x4 accL = (f32x4){0.f, 0.f, 0.f, 0.f}, accA = accL;
#pragma unroll
        for (int s = 0; s < 4; ++s) { const bf16x8v ki = *(const LAS bf16x8v*)(Kb + (16 * ti + r16) * GQS + 32 * s + 8 * q4); const bf16x8v kj = *(const LAS bf16x8v*)(Kb + (16 * tj + r16) * GQS + 32 * s + 8 * q4);
            const bf16x8v qi = *(const LAS bf16x8v*)(Qb + (16 * ti + r16) * GQS + 32 * s + 8 * q4);
            accL = mfma16(ki, kj, accL);
            accA = mfma16(kj, qi, accA); }
        { const int j = 16 * tj + r16, i0 = 16 * ti + 4 * q4; const float gj = gcs[j];
          float val[4];
#pragma unroll
          for (int r = 0; r < 4; ++r) { const int i = i0 + r; const float e = __expf(fminf(gcs[i] - gj, 0.f)); val[r] = (j < i) ? bts[i] * accL[r] * e : 0.f; }
          *(LAS f32x4*)(LT + j * 64 + i0) = (f32x4){val[0], val[1], val[2], val[3]}; }
        { const int i = 16 * ti + r16, j0 = 16 * tj + 4 * q4; const float gi = gcs[i];
          float val[4];
#pragma unroll
          for (int r = 0; r < 4; ++r) { const int j = j0 + r; const float e = __expf(fminf(gi - gcs[j], 0.f)); val[r] = (j <= i) ? accA[r] * e : 0.f; }
          v2u w; w.x = pk2(val[0], val[1]); w.y = pk2(val[2], val[3]); *(GAS v2u*)(AM + (size_t)(ch0 + p) * 4096 + i * 64 + j0) = w; }
    }
    for (int job = NWAVES - 1 - wave; job < 12; job += NWAVES) {
        const int p = job >= 6 ? 1 : 0, u = job - 6 * p;
        const int ti = u < 3 ? 0 : (u < 5 ? 1 : 2), tj = u < 3 ? u + 1 : (u < 5 ? u - 1 : 3);
        *(GAS v2u*)(AM + (size_t)(ch0 + p) * 4096 + (16 * ti + r16) * 64 + 16 * tj + 4 * q4) = (v2u){0u, 0u};
    }
}

__device__ __forceinline__ void p2a_gdn_chunks(const Ctx& F) {
    PHASE_TID();
#define P2A_WS(name) unsigned char* name = F.ws; asm volatile("" : "+s"(name))
    constexpr int NPAIR = BATCH * DNH * (SEQ / CHUNK) / 2;
    const int tid0 = tid;
    const bool solver = wave < 4;
    if (F.vcu >= NPAIR) return;
    { P2A_WS(w0); p2a_tables(F, F.vcu, GA_TB, tid0, (const float*)(w0 + WS_BA), (float*)(w0 + WS_GGL)); }
    __syncthreads();
    { P2A_WS(w0); int tl_ = tid0; asm volatile("" : "+v"(tl_)); p2a_prep_block(F, F.vcu, GA_TB, tl_ >> 4, tl_ & 15, (const bf16*)(w0 + WS_C), (bf16*)(w0 + WS_GQG)); }
    __syncthreads();
    { P2A_WS(w0); int tl_ = tid0; asm volatile("" : "+v"(tl_)); p2a_tiles(F, F.vcu, GA_TB, wave, tl_ & 15, (tl_ & 63) >> 4, (bf16*)(w0 + WS_GAM)); }
    __syncthreads();
    int itn = 0;
    for (int pr = F.vcu; pr < NPAIR; pr += F.G, ++itn) {
        const int tb_off = GA_TB + (itn & 1) * 2048, tb_nxt = GA_TB + ((itn + 1) & 1) * 2048;
        const bool has_next = pr + F.G < NPAIR;
        const int ch0 = 2 * pr;
        int t3_ = tid0; asm volatile("" : "+v"(t3_));
        if (solver) {
            const int p = t3_ >> 7, c = t3_ & 127;
            const LAS bf16* Kb = (const LAS bf16*)(F.lds + p * GA_SZ + GA_KB); const LAS bf16* Vb = (const LAS bf16*)(F.lds + p * GA_SZ + GA_VB);
            LAS bf16* Wl = (LAS bf16*)(F.lds + p * GA_SZ + GA_LM);
            unsigned lmv = (unsigned)(size_t)(F.lds + p * GA_SZ + GA_LM), gcv = (unsigned)(size_t)(F.lds + tb_off + p * 1024); asm volatile("" : "+v"(lmv), "+v"(gcv));
            const LAS float* LTv = (const LAS float*)lmv; const LAS float* btv = (const LAS float*)(gcv + 256); const LAS float* egv = (const LAS float*)(gcv + 512); const LAS float* edv = (const LAS float*)(gcv + 768);
            const size_t chp = (size_t)(ch0 + p);
            P2A_WS(w1); bf16* KDT = (bf16*)(w1 + WS_GKD);
            f32x2v_ R[64];
#pragma unroll
            for (int i = 0; i < 64; ++i) { const float bt = btv[i]; R[i] = (f32x2v_){bt * bf2f(Vb[i * 128 + c]), bt * egv[i] * bf2f(Kb[i * GQS + c])};
                asm volatile("" : "+v"(R[i]));
                if ((i & 7) == 7) __builtin_amdgcn_sched_barrier(0); }
#pragma unroll
            for (int g8 = 0; g8 < 8; ++g8) { float kd[8];
#pragma unroll
                for (int e = 0; e < 8; ++e) kd[e] = bf2f(Kb[(8 * g8 + e) * GQS + c]) * edv[8 * g8 + e];
                *(GAS v4u*)(KDT + chp * 8192 + c * 64 + 8 * g8) = pack8(kd);
                __builtin_amdgcn_sched_barrier(0); }
            P2A_LBAR();
            f32x4 la[8], lb[8];
            subst_load<0, 0>(la, LTv);
            subst_all(R, la, lb, LTv, std::make_integer_sequence<int, 63>{});
            P2A_LBAR();
            P2A_WS(w3); bf16* UT = (bf16*)(w3 + WS_GUT);
#pragma unroll
            for (int g8 = 0; g8 < 8; ++g8) { v4u o; o.x = pk2(R[8 * g8].x, R[8 * g8 + 1].x); o.y = pk2(R[8 * g8 + 2].x, R[8 * g8 + 3].x); o.z = pk2(R[8 * g8 + 4].x, R[8 * g8 + 5].x); o.w = pk2(R[8 * g8 + 6].x, R[8 * g8 + 7].x);
                *(GAS v4u*)(UT + chp * 8192 + c * 64 + 8 * g8) = o; }
#pragma unroll
            for (int i = 0; i < 64; ++i) Wl[i * 128 + c] = (bf16)f2bf(-R[i].y);
        } else {
            const int tp = t3_ - 256;
            if (has_next) { P2A_WS(w1); p2a_tables(F, pr + F.G, tb_nxt, tp, (const float*)(w1 + WS_BA), (float*)(w1 + WS_GGL)); }
            P2A_LBAR();
            if (has_next) {
#pragma unroll 1
                for (int pass = 0; pass < 2; ++pass) { P2A_WS(w2); int tq_ = tp; asm volatile("" : "+v"(tq_));
                    p2a_prep_block(F, pr + F.G, tb_nxt, (tq_ >> 4) + 16 * pass, tq_ & 15, (const bf16*)(w2 + WS_C), (bf16*)(w2 + WS_GQG)); }
            }
            P2A_LBAR();
        }
        P2A_LBAR();
        { P2A_WS(w4); bf16* WM = (bf16*)(w4 + WS_GWM); int tl_ = tid0; asm volatile("" : "+v"(tl_));
#pragma unroll
          for (int k = 0; k < 4; ++k) { const int idx = tl_ + 512 * k, p = idx >> 10, id = idx & 1023;
              *(GAS v4u*)(WM + (size_t)(ch0 + p) * 8192 + id * 8) = *(const LAS v4u*)((const LAS bf16*)(F.lds + p * GA_SZ + GA_LM) + id * 8); } }
        P2A_LBAR();
        if (has_next) { P2A_WS(w5); int tl_ = tid0; asm volatile("" : "+v"(tl_)); p2a_tiles(F, pr + F.G, tb_nxt, wave, tl_ & 15, (tl_ & 63) >> 4, (bf16*)(w5 + WS_GAM)); }
        P2A_LBAR();
    }
}
#undef P2A_WS
#undef P2A_LBAR

__device__ __forceinline__ void p2b_gdn_scan(const Ctx& F) {
    PHASE_TID();
    constexpr int STS = 136, VNS = 72;
    constexpr int OP0 = 32 * STS * 2 + 32 * VNS * 2;
    constexpr int O_WM = 0, O_QG = 64 * 272, O_AM = 2 * 64 * 272, O_KD = O_AM + 64 * 144, OPB = O_KD + 128 * 144;
    static_assert(OP0 + 2 * OPB <= LDSCTL_OFF, "scan LDS map");
    LAS bf16* ST = (LAS bf16*)F.lds; LAS bf16* VN = (LAS bf16*)(F.lds + 32 * STS * 2);
    const bf16* WM = (const bf16*)(F.ws + WS_GWM); const bf16* UT = (const bf16*)(F.ws + WS_GUT); const bf16* QG = (const bf16*)(F.ws + WS_GQG); const bf16* KDT = (const bf16*)(F.ws + WS_GKD);
    const bf16* AM = (const bf16*)(F.ws + WS_GAM); const float* GL = (const float*)(F.ws + WS_GGL); bf16* OR = (bf16*)(F.ws + WS_OR);
    const int q4 = lane >> 4, r16 = lane & 15, it_ = wave >> 1, dt = wave & 1;
    struct Stage { v4u g[7]; v2u ut; float gl; };
    unsigned lw[7];
#pragma unroll
    for (int k = 0; k < 2; ++k) { const int i = tid + 512 * k; lw[k] = O_WM + (i >> 4) * 272 + (i & 15) * 16; lw[2 + k] = O_QG + (i >> 4) * 272 + (i & 15) * 16; lw[5 + k] = O_KD + (i >> 3) * 144 + (i & 7) * 16; }
    lw[4] = O_AM + (tid >> 3) * 144 + (tid & 7) * 16;
    for (int item = F.vcu; item < BATCH * DNH * 4; item += F.G) {
        const int b = item >> 4, h = (item >> 2) & 3, dvq = item & 3;
        const int ch0 = (b * 4 + h) * 32;
        for (int idx = tid; idx < 32 * STS / 2; idx += NWAVES * 64) ((LAS unsigned*)ST)[idx] = 0u;
        f32x4 Sacc[2]; Sacc[0] = (f32x4){0.f, 0.f, 0.f, 0.f}; Sacc[1] = Sacc[0];
#define GDN_ISSUE(S, chx) do { const size_t cb = (size_t)(chx); \
            _Pragma("unroll") for (int k = 0; k < 2; ++k) { (S).g[k] = *(const GAS v4u*)(WM + cb * 8192 + (size_t)(tid + 512 * k) * 8); (S).g[2 + k] = *(const GAS v4u*)(QG + cb * 8192 + (size_t)(tid + 512 * k) * 8); \
                (S).g[5 + k] = *(const GAS v4u*)(KDT + cb * 8192 + (size_t)(tid + 512 * k) * 8); } \
            (S).g[4] = *(const GAS v4u*)(AM + cb * 4096 + (size_t)tid * 8); \
            (S).ut = *(const GAS v2u*)(UT + cb * 8192 + (dvq * 32 + 16 * dt + r16) * 64 + 16 * it_ + 4 * q4); (S).gl = GL[cb]; } while (0)
#define GDN_WRITE(S, buf) do { _Pragma("unroll") for (int k = 0; k < 7; ++k) *(LAS v4u*)(F.lds + OP0 + (buf) * OPB + lw[k]) = (S).g[k]; } while (0)
#define GDN_LBAR() do { asm volatile("s_waitcnt lgkmcnt(0)" ::: "memory"); __builtin_amdgcn_s_barrier(); asm volatile("" ::: "memory"); } while (0)
        Stage S0, S1, S2;
        GDN_ISSUE(S0, ch0); GDN_ISSUE(S1, ch0 + 1); GDN_ISSUE(S2, ch0 + 2); GDN_WRITE(S0, 0);
        GDN_LBAR();
#define GDN_STEP(SC, SW, cc) do { const int c = (cc); const int bufc = c & 1; \
            const v2u utc = (SC).ut; const float glc = (SC).gl; \
            { const int cl = (c + 3 < SEQ / CHUNK) ? c + 3 : SEQ / CHUNK - 1; GDN_ISSUE(SC, ch0 + cl); } \
            const LAS unsigned char* ob = F.lds + OP0 + bufc * OPB; \
            bf16x8v sf[4], wf[4], qf[4]; \
            _Pragma("unroll") for (int s = 0; s < 4; ++s) { sf[s] = *(const LAS bf16x8v*)(ST + (16 * dt + r16) * STS + 32 * s + 8 * q4); \
                wf[s] = *(const LAS bf16x8v*)(ob + O_WM + (16 * it_ + r16) * 272 + (32 * s + 8 * q4) * 2); qf[s] = *(const LAS bf16x8v*)(ob + O_QG + (16 * it_ + r16) * 272 + (32 * s + 8 * q4) * 2); } \
            f32x4 vacc = (f32x4){bflo(utc.x), bfhi(utc.x), bflo(utc.y), bfhi(utc.y)}; \
            f32x4 oacc = (f32x4){0.f, 0.f, 0.f, 0.f}; \
            _Pragma("unroll") for (int s = 0; s < 4; ++s) { vacc = mfma16(wf[s], sf[s], vacc); oacc = mfma16(sf[s], qf[s], oacc); } \
            { v2u w; w.x = pk2(vacc[0], vacc[1]); w.y = pk2(vacc[2], vacc[3]); *(LAS v2u*)(VN + (16 * dt + r16) * VNS + 16 * it_ + 4 * q4) = w; } \
            GDN_LBAR(); \
            bf16x8v vf[2][2], af[2], kf[2]; \
            _Pragma("unroll") for (int s = 0; s < 2; ++s) { af[s] = *(const LAS bf16x8v*)(ob + O_AM + (16 * it_ + r16) * 144 + (32 * s + 8 * q4) * 2); kf[s] = *(const LAS bf16x8v*)(ob + O_KD + (16 * wave + r16) * 144 + (32 * s + 8 * q4) * 2); } \
            _Pragma("unroll") for (int t = 0; t < 2; ++t) _Pragma("unroll") for (int s = 0; s < 2; ++s) vf[t][s] = *(const LAS bf16x8v*)(VN + (16 * t + r16) * VNS + 32 * s + 8 * q4); \
            _Pragma("unroll") for (int s = 0; s < 2; ++s) { const bf16x8v vo = *(const LAS bf16x8v*)(VN + (16 * dt + r16) * VNS + 32 * s + 8 * q4); oacc = mfma16(vo, af[s], oacc); } \
            { v2u w; w.x = pk2(oacc[0], oacc[1]); w.y = pk2(oacc[2], oacc[3]); *(GAS v2u*)(OR + ((size_t)b * SEQ + c * CHUNK + 16 * it_ + r16) * DNW + h * 128 + dvq * 32 + 16 * dt + 4 * q4) = w; } \
            _Pragma("unroll") for (int t = 0; t < 2; ++t) { Sacc[t] = Sacc[t] * glc; \
                _Pragma("unroll") for (int s = 0; s < 2; ++s) Sacc[t] = mfma16(kf[s], vf[t][s], Sacc[t]); \
                v2u w; w.x = pk2(Sacc[t][0], Sacc[t][1]); w.y = pk2(Sacc[t][2], Sacc[t][3]); *(LAS v2u*)(ST + (16 * t + r16) * STS + 16 * wave + 4 * q4) = w; } \
            GDN_WRITE(SW, bufc ^ 1); \
            GDN_LBAR(); \
        } while (0)
#pragma unroll 1
        for (int c3 = 0; c3 < SEQ / CHUNK; c3 += 3) { GDN_STEP(S0, S1, c3); if (c3 + 1 < SEQ / CHUNK) GDN_STEP(S1, S2, c3 + 1); if (c3 + 2 < SEQ / CHUNK) GDN_STEP(S2, S0, c3 + 2); }
#undef GDN_STEP
#undef GDN_LBAR
#undef GDN_WRITE
#undef GDN_ISSUE
    }
}

__device__ __forceinline__ void p3_mixer_finish(const Ctx& F) {
    PHASE_TID();
    const int gw = F.vcu * NWAVES + wave, NGW = F.G * NWAVES;
    const bf16* PROJ = (const bf16*)(F.ws + WS_C); const bf16* OR = (const bf16*)(F.ws + WS_OR); bf16* Y = (bf16*)(F.ws + WS_Y);
    const int c0 = lane * 8, grp = lane >> 4, win = 2 << grp;
    float gn[8];
    { const f32x4* p = (const f32x4*)(F.g_dn + (c0 & 127)); const f32x4 a = p[0], b = p[1];
#pragma unroll
      for (int e = 0; e < 4; ++e) { gn[e] = a[e]; gn[4 + e] = b[e]; } }
    for (int blk = gw; blk < M / 4; blk += NGW) {
        const int m0 = blk * 4, tok0 = m0 & (SEQ - 1);
        v4u wl[19], zw[4], ow[4];
#pragma unroll
        for (int r = 0; r < 19; ++r) { const int back = 15 - r; const size_t rr = (tok0 - back >= 0) ? (size_t)(m0 - back) : (size_t)m0; wl[r] = *(const GAS v4u*)(PROJ + rr * NPROJ + c0); }
#pragma unroll
        for (int e = 0; e < 4; ++e) { zw[e] = __builtin_nontemporal_load((const GAS v4u*)(PROJ + (size_t)(m0 + e) * NPROJ + 2048 + c0)); ow[e] = __builtin_nontemporal_load((const GAS v4u*)(OR + (size_t)(m0 + e) * DNW + c0)); }
        float S[8];
#pragma unroll
        for (int c = 0; c < 8; ++c) S[c] = 0.f;
        { const int cnt0 = (tok0 + 1) < win ? (tok0 + 1) : win;
#pragma unroll
          for (int i = 0; i < 16; ++i) { float f[8]; unpack8(wl[15 - i], f); const bool on = i < cnt0;
#pragma unroll
              for (int c = 0; c < 8; ++c) S[c] += on ? f[c] : 0.f; } }
#pragma unroll
        for (int e = 0; e < 4; ++e) {
            float u0[8]; unpack8(wl[15 + e], u0);
            if (e > 0) {
                const v4u sel = win == 2 ? wl[13 + e] : (win == 4 ? wl[11 + e] : (win == 8 ? wl[7 + e] : wl[e > 0 ? e - 1 : 0]));
                float fs[8]; unpack8(sel, fs); const bool sub = tok0 + e - win >= 0;
#pragma unroll
                for (int c = 0; c < 8; ++c) S[c] += u0[c] - (sub ? fs[c] : 0.f);
            }
            const int tk = tok0 + e; const int cnt = (tk + 1) < win ? (tk + 1) : win; const float ic = 1.0f / (float)cnt;
            v4u o; o.x = pk2(S[0] * ic - u0[0], S[1] * ic - u0[1]); o.y = pk2(S[2] * ic - u0[2], S[3] * ic - u0[3]); o.z = pk2(S[4] * ic - u0[4], S[5] * ic - u0[5]); o.w = pk2(S[6] * ic - u0[6], S[7] * ic - u0[7]);
            *(GAS v4u*)(Y + (size_t)(m0 + e) * D + c0) = o;
            float ov[8]; unpack8(ow[e], ov);
            float ss = 0.f;
#pragma unroll
            for (int c = 0; c < 8; ++c) ss += ov[c] * ov[c];
            ss = row16_sum(ss);
            const float rs = 1.0f / sqrtf(ss * (1.0f / 128.0f) + 1e-6f);
            float z[8]; unpack8(zw[e], z);
            float y[8];
#pragma unroll
            for (int c = 0; c < 8; ++c) y[c] = ov[c] * rs * gn[c] * silu_f(z[c]);
            v4u o2; o2.x = pk2(y[0], y[1]); o2.y = pk2(y[2], y[3]); o2.z = pk2(y[4], y[5]); o2.w = pk2(y[6], y[7]);
            *(GAS v4u*)(Y + (size_t)(m0 + e) * D + 512 + c0) = o2;
        }
    }
}

__device__ __forceinline__ void p10_final_norm(const Ctx& F) {
    PHASE_TID();
    const int gw = F.vcu * NWAVES + wave, NGW = F.G * NWAVES;
    f32x4 gv[4];
#pragma unroll
    for (int j = 0; j < 4; ++j) gv[j] = ((const f32x4*)F.g_fin)[lane + 64 * j];
    for (int m = gw; m < M; m += NGW) {
        GAS f32x4* xr = (GAS f32x4*)(F.out + (size_t)m * D) + lane;
        f32x4 v[4]; float s = 0.f;
#pragma unroll
        for (int j = 0; j < 4; ++j) { v[j] = xr[64 * j]; s += (v[j][0] * v[j][0] + v[j][1] * v[j][1]) + (v[j][2] * v[j][2] + v[j][3] * v[j][3]); }
        const float rs = 1.0f / sqrtf(wave_sum(s) * (1.0f / D) + pg8::RMS_EPS);
#pragma unroll
        for (int j = 0; j < 4; ++j) xr[64 * j] = v[j] * rs * gv[j];
    }
}

struct Args { const float* in[21]; float* out; unsigned char* ws; int ph_lo, ph_hi, li, pad; };
__global__ void __launch_bounds__(NWAVES * 64, 2) hymba_fwd(Args args) {
    extern __shared__ __attribute__((aligned(16))) unsigned char lds[];
    Ctx F;
    F.lds = (LAS unsigned char*)lds;
    volatile LAS unsigned* MISC = (volatile LAS unsigned*)(F.lds + MISC_OFF);
    F.G = gridDim.x; { const int bx = blockIdx.x; F.vcu = (F.G % 8 == 0) ? (bx % 8) * (F.G / 8) + bx / 8 : bx; }
    F.x = args.in[0]; F.mem = args.in[1]; F.g_mix = args.in[2]; F.w_in = args.in[3]; F.w_pool = args.in[4]; F.pool_scale = args.in[5]; F.conv_w = args.in[6]; F.a_log = args.in[7];
    F.dt_bias = args.in[8]; F.g_dn = args.in[9]; F.w_out = args.in[10]; F.g_xa = args.in[11]; F.g_mem = args.in[12]; F.w_xq = args.in[13]; F.w_xk = args.in[14]; F.w_xv = args.in[15];
    F.w_xo = args.in[16]; F.g_mlp = args.in[17]; F.w_up = args.in[18]; F.w_down = args.in[19]; F.g_fin = args.in[20];
    F.out = args.out; F.ws = args.ws;
    unsigned char* ws = args.ws;
    gu32* ctl = (gu32*)(ws + WS_CTL);
    for (int u = threadIdx.x; u < (LDS_BYTES - LDSCTL_OFF) / 4; u += NWAVES * 64) ((LAS unsigned*)(F.lds + LDSCTL_OFF))[u] = 0u;
    __syncthreads();
    XcdBarrier bar; bar.bar = (unsigned*)(ctl + CW_BAR); bar.x = 0; bar.st = nullptr;
    if (N_LAUNCHES == 1) bar = xcd_barrier_post((unsigned*)(ctl + CW_BAR), MISC + 8);
#define GRID_BAR() do { if (N_LAUNCHES == 1) { xcd_barrier(bar); if (PROBE_REP == 100) xcd_barrier(bar); } } while (0)
    const int lo = args.ph_lo, hi = args.ph_hi;
#define IN(k) (lo <= (k) && (k) < hi)
#define NREP(k) ((PROBE_REP == (k)) ? 2 : 1)
#define BOTH(k) (IN(k) && IN((k) + 1))
    using namespace pg8;
    bf16_t* WIN = (bf16_t*)(ws + WS_WIN); bf16_t* WOUT = (bf16_t*)(ws + WS_WOUT); bf16_t* WQ = (bf16_t*)(ws + WS_WQ); bf16_t* WK = (bf16_t*)(ws + WS_WK);
    bf16_t* WV = (bf16_t*)(ws + WS_WV); bf16_t* WO = (bf16_t*)(ws + WS_WO); bf16_t* WUP = (bf16_t*)(ws + WS_WUP); bf16_t* WDN = (bf16_t*)(ws + WS_WDN);
    bf16_t* MN = (bf16_t*)(ws + WS_MN); bf16_t* KM = (bf16_t*)(ws + WS_KM); bf16_t* VT = (bf16_t*)(ws + WS_VT);
    bf16_t* RA = (bf16_t*)(ws + WS_A); bf16_t* RB = (bf16_t*)(ws + WS_B); bf16_t* RC = (bf16_t*)(ws + WS_C); bf16_t* PS = (bf16_t*)(ws + WS_PS);
    float* SSQ1 = (float*)(ws + WS_SSQ1); float* SSQ2 = (float*)(ws + WS_SSQ2); float* SSQ3 = (float*)(ws + WS_SSQ3);
    const int bx = (int)blockIdx.x;

    if (IN(0)) { for (int rep = 0; rep < NREP(0); ++rep) { p0_prologue(F); __syncthreads(); } if (BOTH(0)) GRID_BAR(); }
    if (IN(1)) {
        for (int rep = 0; rep < NREP(1); ++rep) {
        { Gemm g{RA, WIN, 1024, 1024, 1024}; StaticOrder S; S.init(M, NPROJ, F.G, bx); EpiStore<0, true> E{RC, NPROJ, (const float*)(ws + WS_SSQ0)};
          gemm_phase<EpiStore<0, true>, StaticOrder, true, true>(F.lds, g, S, E); }
        { Gemm g{MN, WK, 1024, 1024, 1024}; StaticOrder S; S.init(MROWS, 1024, F.G, bx); EpiStore<0, false> E{KM, 1024, nullptr};
          gemm_phase<EpiStore<0, false>, StaticOrder, true, true>(F.lds, g, S, E); }
        { Gemm g{WV, MN, 1024, 1024, 1024}; StaticOrder S; S.init(1024, MROWS, F.G, (bx + F.G / 2) % F.G); EpiStore<0, false> E{VT, MROWS, nullptr};
          gemm_phase<EpiStore<0, false>, StaticOrder, true, true>(F.lds, g, S, E); }
        }
        { const int q = F.G / 4; const int seg = bx / q; if ((seg & 1) && F.G % 4 == 0) late_weight_copies(F, (seg >> 1) * q + (bx - seg * q), 2 * q); else if (F.G % 4 != 0 && bx == 0) {   } }
        if (F.G % 4 != 0) late_weight_copies(F, bx, F.G);
        if (BOTH(1)) GRID_BAR();
    }
    if (IN(2)) { for (int rep = 0; rep < NREP(2); ++rep) { p2a_gdn_chunks(F); __syncthreads(); } if (BOTH(2)) GRID_BAR(); }
    if (IN(3)) { for (int rep = 0; rep < NREP(3); ++rep) { p2b_gdn_scan(F); __syncthreads(); } if (BOTH(3)) GRID_BAR(); }
    if (IN(4)) { for (int rep = 0; rep < NREP(4); ++rep) { p3_mixer_finish(F); __syncthreads(); } if (BOTH(4)) GRID_BAR(); }
    if (IN(5)) {
        Gemm g{(const bf16_t*)(ws + WS_Y), WOUT, 1024, 1024, 1024}; StaticOrder S; S.init(M, D, F.G, bx); EpiResid<0> E{(const float*)RA, RB, SSQ1, nullptr, nullptr, nullptr};
        gemm_phase<EpiResid<0>, StaticOrder, true, true>(F.lds, g, S, E);
        if (BOTH(5)) GRID_BAR();
    }
    if (IN(7)) {
        for (int rep = 0; rep < NREP(7); ++rep)
        for (int u0 = F.vcu; u0 < (M / 256) * 4; u0 += 2 * F.G) {
            const int u1 = u0 + F.G, nu = (u1 < (M / 256) * 4) ? 2 : 1;
            const int rt0 = u0 >> 2, h0 = u0 & 3, b0 = rt0 >> 3, rt1 = (nu > 1 ? u1 : u0) >> 2, h1 = (nu > 1 ? u1 : u0) & 3, b1 = rt1 >> 3;
            { Gemm g{RB, WQ, 1024, 1024, 1024}; PairUnits S{Unit{rt0, h0, 0, 0, 0}, Unit{rt1, h1, 0, 0, 0}, nu}; EpiStore<0, true> E{RC, 1024, SSQ1};
              gemm_phase<EpiStore<0, true>, PairUnits, true, true>(F.lds, g, S, E); }
            VM_WAIT(); __syncthreads();
            { Gemm g{RC, KM, 1024, 1024, 256}; PairUnits S{Unit{rt0, b0, (long)h0 * 512, (long)h0 * 512, u0}, Unit{rt1, b1, (long)h1 * 512, (long)h1 * 512, nu > 1 ? u1 : u0}, nu};
              EpiSoftmaxS E{PS, 0.0625f * 1.4426950408889634f, F.lds + RING_BYTES};
              gemm_phase<EpiSoftmaxS, PairUnits, true, true>(F.lds, g, S, E); }
            VM_WAIT(); __syncthreads();
            { Gemm g{PS, VT, 256, MROWS, 256};
              PairUnits S{Unit{rt0, h0, (long)u0 * 131072 - (long)rt0 * 131072, (long)b0 * 512, 0}, Unit{rt1, h1, (long)(nu > 1 ? u1 : u0) * 131072 - (long)rt1 * 131072, (long)b1 * 512, 0}, nu};
              EpiStore<0, false> E{RA, 1024, nullptr};
              gemm_phase<EpiStore<0, false>, PairUnits, true, true>(F.lds, g, S, E); }
            __syncthreads();
        }
        if (BOTH(7)) GRID_BAR();
    }
    if (IN(8)) {
        Gemm g{RA, WO, 1024, 1024, 1024}; StaticOrder S; S.init(M, D, F.G, bx); EpiResid<1> E{nullptr, RB, SSQ2, nullptr, nullptr, nullptr};
        gemm_phase<EpiResid<1>, StaticOrder, true, true>(F.lds, g, S, E);
        if (BOTH(8)) GRID_BAR();
    }
    if (IN(9)) {
        Gemm g{RB, WUP, 1024, 1024, 1024}; StaticOrder S; S.init(M, FF, F.G, bx); EpiStore<1, true> E{RC, FF, SSQ2};
        for (int rep = 0; rep < NREP(9); ++rep) gemm_phase<EpiStore<1, true>, StaticOrder, true, true>(F.lds, g, S, E);
        if (BOTH(9)) GRID_BAR();
    }
    if (IN(10)) {
        Gemm g{RC, WDN, 64, FF, FF, (size_t)32768, (size_t)(FF / 64) * 32768};     StaticOrder S; S.init(M, D, F.G, bx); EpiResid<2> E{nullptr, RB, SSQ3, F.out, F.g_fin, (unsigned*)(ws + WS_CNT3)};
        gemm_phase<EpiResid<2>, StaticOrder, true, true>(F.lds, g, S, E);
    }
#undef IN
#undef BOTH
}

extern "C" void kernel_launch(void* const* d_in, const int* in_sizes, int n_in, void* d_out, int out_size, void* d_ws, size_t ws_size, hipStream_t stream) {
    static int grid = 0;
    if (grid == 0) {
        if (n_in != 21 || in_sizes[0] != M * D || out_size != M * D || ws_size < WS_END) { fprintf(stderr, "kernel_launch: unexpected shapes (n_in %d, in0 %d, out %d, ws %zu); nothing launched\n", n_in, n_in > 0 ? in_sizes[0] : -1, out_size, ws_size); grid = -1; return; }
        int dev = 0, cus = 0, per_cu = 0;
        if (hipGetDevice(&dev) != hipSuccess || hipDeviceGetAttribute(&cus, hipDeviceAttributeMultiprocessorCount, dev) != hipSuccess) { fprintf(stderr, "kernel_launch: device query failed\n"); grid = -1; return; }
        if (hipFuncSetAttribute((const void*)hymba_fwd, hipFuncAttributeMaxDynamicSharedMemorySize, LDS_BYTES) != hipSuccess) { fprintf(stderr, "kernel_launch: hipFuncSetAttribute failed\n"); grid = -1; return; }
        if (hipOccupancyMaxActiveBlocksPerMultiprocessor(&per_cu, (const void*)hymba_fwd, NWAVES * 64, LDS_BYTES) != hipSuccess || per_cu < 1) { fprintf(stderr, "kernel_launch: occupancy query reports %d blocks per CU\n", per_cu); per_cu = 1; }
        (void)hipGetLastError();
        grid = cus;
    }
    if (grid < 0) return;
    if (hipMemsetAsync((char*)d_ws + WS_CTL, 0, CTL_ZERO_BYTES, stream) != hipSuccess) { fprintf(stderr, "kernel_launch: memset failed\n"); return; }
    Args a{};
    for (int i = 0; i < 21; ++i) a.in[i] = (const float*)d_in[i];
    a.out = (float*)d_out; a.ws = (unsigned char*)d_ws;
    for (int li = 0; li < N_LAUNCHES; ++li) {
        a.ph_lo = (N_LAUNCHES == 1) ? 0 : li; a.ph_hi = (N_LAUNCHES == 1) ? N_PHASES : li + 1; a.li = li;
        hipLaunchKernelGGL(hymba_fwd, dim3(grid), dim3(NWAVES * 64), LDS_BYTES, stream, a);
        const hipError_t le = hipPeekAtLastError();
        if (le != hipSuccess) { fprintf(stderr, "kernel_launch: launch %d failed: %s\n", li, hipGetErrorName(le)); break; }
    }
}
```

```cpp
#include <hip/hip_runtime.h>
#include <cstdio>
#include <cstdint>
#include <utility>

#ifndef PROBE_REP
#define PROBE_REP -1
#endif
#ifndef MK_N_LAUNCHES
#define MK_N_LAUNCHES 1
#endif

namespace pg8 {
#define PG8_LAS __attribute__((address_space(3)))
typedef unsigned short bf16_t;
typedef short bf16x8 __attribute__((ext_vector_type(8)));
typedef float f32x4 __attribute__((ext_vector_type(4)));
typedef unsigned u32x4 __attribute__((ext_vector_type(4)));
typedef unsigned u32x2 __attribute__((ext_vector_type(2)));
constexpr int BM = 256, BK = 64, HALF = 128, HTB = HALF * BK * 2  , STAGE_BYTES = 8 * HTB, NXCD = 8, WGM = 4;

__host__ __device__ __forceinline__ int lds_byte(int r, int c) { const int st = (r >> 4) * 2 + (c >> 5), rr = r & 15, cc = c & 31, ob = rr * 64 + cc * 2; return st * 1024 + (ob ^ (((ob >> 9) & 1) << 5)); }
__host__ __device__ __forceinline__ void stage_rc(int b, int& R, int& C) { const int st = b / 1024, sb = b % 1024, swz = sb ^ (((sb >> 9) & 1) << 5); R = (st >> 1) * 16 + swz / 64; C = (st & 1) * 32 + (swz % 64) / 2; }
__host__ __device__ __forceinline__ int perm32(int rho) { const int n = rho >> 4, i = rho & 15; return 8 * (i >> 2) + 4 * n + (i & 3); }
__host__ __device__ __forceinline__ int perm2(int h, int rho) { return 64 * (rho >> 5) + 32 * h + 8 * ((rho >> 2) & 3) + 4 * ((rho >> 4) & 1) + (rho & 3); }

struct Unit { int pm, pn; long ao, bo; int id; };
struct Gemm { const bf16_t* A; const bf16_t* Bt; int lda, ldb, K; size_t akstep = 0, atstep = 0; };

struct StaticOrder {
    int nM, nN, nwg, G, c;
    __host__ __device__ void init(int M, int N, int G_, int c_) { nM = M / BM; nN = N / BM; nwg = nM * nN; G = G_; c = c_; }
    __host__ __device__ bool next(int i, Unit& u) const {
        const long L = (long)i * G + c; if (L >= nwg) return false;
        int wgid = (int)L; { const int q = nwg / NXCD, r = nwg % NXCD, xcd = wgid % NXCD, off = wgid / NXCD; wgid = (xcd < r ? xcd * (q + 1) : r * (q + 1) + (xcd - r) * q) + off; }
        const int nig = WGM * nN, gid = wgid / nig, fm = gid * WGM, gsz = (nM - fm) < WGM ? (nM - fm) : WGM;
        u.pm = fm + ((wgid % nig) % gsz); u.pn = (wgid % nig) / gsz; u.ao = 0; u.bo = 0; u.id = 0; return true;
    }
    __device__ __forceinline__ void a_ready(const Unit&) const {}
    __device__ __forceinline__ void done(const Unit&) const {}
};
struct OneUnit {
    int pm, pn;
    __device__ __forceinline__ bool next(int i, Unit& u) const { if (i != 0) return false; u.pm = pm; u.pn = pn; u.ao = 0; u.bo = 0; u.id = 0; return true; }
    __device__ __forceinline__ void a_ready(const Unit&) const {}
    __device__ __forceinline__ void done(const Unit&) const {}
};

struct PairUnits {
    Unit u0, u1; int n;
    __device__ __forceinline__ bool next(int i, Unit& u) const { if (i >= n) return false; u = i ? u1 : u0; return true; }
    __device__ __forceinline__ void a_ready(const Unit&) const {}
    __device__ __forceinline__ void done(const Unit&) const {}
};

__device__ __forceinline__ unsigned cvt_pk_bf16(float lo, float hi) { unsigned r; asm volatile("v_cvt_pk_bf16_f32 %0, %1, %2" : "=v"(r) : "v"(lo), "v"(hi)); return r; }

constexpr float RMS_EPS = 1e-6f;
__device__ __forceinline__ float rs_from_ssq(const float* ssq, int row) { return 1.0f / sqrtf(ssq[row] * (1.0f / 1024.0f) + RMS_EPS); }

template <int ACT, bool RS> struct EpiStore {
    static constexpr bool PERM = true, AFTER_DRAIN = false;
    bf16_t* O; int ldc; const float* ssq;
    __device__ __forceinline__ void operator()(const f32x4 (&acc)[2][2][4][2], const Unit& u, int wr, int wc, int fr, int fq) const {
        const int row0 = u.pm * BM + wr * 64 + fr, col0 = u.pn * BM + wc * 64 + 8 * fq;
        float rsv[2][4];
#pragma unroll
        for (int ai = 0; ai < 2; ++ai)
#pragma unroll
            for (int m = 0; m < 4; ++m) rsv[ai][m] = RS ? ssq[row0 + ai * HALF + m * 16] : 0.f;
#pragma unroll
        for (int ai = 0; ai < 2; ++ai)
#pragma unroll
            for (int m = 0; m < 4; ++m) { const int row = row0 + ai * HALF + m * 16;
                bf16_t* rowp = (ACT == 1) ? O + ((size_t)(row >> 8) * (ldc >> 6) + (col0 >> 6)) * 16384 + (size_t)(row & 255) * 64 + (col0 & 63) : O + (size_t)row * ldc + col0;
                float rs = 1.f; if (RS) rs = 1.0f / sqrtf(rsv[ai][m] * (1.0f / 1024.0f) + RMS_EPS);
#pragma unroll
                for (int bj = 0; bj < 2; ++bj) { f32x4 v0 = acc[ai][bj][m][0], v1 = acc[ai][bj][m][1];
                    if (RS) { v0 = v0 * rs; v1 = v1 * rs; }
                    if (ACT == 1) {
#pragma unroll
                        for (int j = 0; j < 4; ++j) { const float a = v0[j] > 0.f ? v0[j] : 0.f, b = v1[j] > 0.f ? v1[j] : 0.f; v0[j] = a * a; v1[j] = b * b; } }
                    u32x4 w; w.x = cvt_pk_bf16(v0[0], v0[1]); w.y = cvt_pk_bf16(v0[2], v0[3]); w.z = cvt_pk_bf16(v1[0], v1[1]); w.w = cvt_pk_bf16(v1[2], v1[3]);
                    *(u32x4*)(rowp + 32 * bj) = w; } }
    }
};
template <int MODE> struct EpiResid {
    static constexpr bool PERM = true, AFTER_DRAIN = false;
    const float* basef; bf16_t* hb; float* ssq; float* out; const float* gfin; unsigned* cnt;
    static __device__ __forceinline__ void unpk(const u32x4 w, f32x4& lo, f32x4& hi) {
        lo = (f32x4){__builtin_bit_cast(float, w.x << 16), __builtin_bit_cast(float, w.x & 0xffff0000u), __builtin_bit_cast(float, w.y << 16), __builtin_bit_cast(float, w.y & 0xffff0000u)};
        hi = (f32x4){__builtin_bit_cast(float, w.z << 16), __builtin_bit_cast(float, w.z & 0xffff0000u), __builtin_bit_cast(float, w.w << 16), __builtin_bit_cast(float, w.w & 0xffff0000u)}; }
    __device__ __forceinline__ void operator()(f32x4 (&acc)[2][2][4][2], const Unit& u, int wr, int wc, int fr, int fq) const {
        const int row0 = u.pm * BM + wr * 64 + fr, col0 = u.pn * BM + wc * 64 + 8 * fq;
#pragma unroll
        for (int ai = 0; ai < 2; ++ai) {
            u32x4 bs[4][2];
#pragma unroll
            for (int m = 0; m < 4; ++m)
#pragma unroll
                for (int bj = 0; bj < 2; ++bj) { const size_t o2 = (size_t)(row0 + ai * HALF + m * 16) * 1024 + col0 + 32 * bj;
                    if (MODE == 0) bs[m][bj] = __builtin_nontemporal_load((const u32x4*)((const bf16_t*)basef + o2));
                    else bs[m][bj] = *(const u32x4*)(hb + o2); }
#pragma unroll
            for (int m = 0; m < 4; ++m) { const int row = row0 + ai * HALF + m * 16; const size_t off = (size_t)row * 1024 + col0; float ss = 0.f;
#pragma unroll
                for (int bj = 0; bj < 2; ++bj) { f32x4 b0, b1; unpk(bs[m][bj], b0, b1);
                    const f32x4 o0 = b0 + acc[ai][bj][m][0], o1 = b1 + acc[ai][bj][m][1];
                    ss += ((o0[0] * o0[0] + o0[1] * o0[1]) + (o0[2] * o0[2] + o0[3] * o0[3])) + ((o1[0] * o1[0] + o1[1] * o1[1]) + (o1[2] * o1[2] + o1[3] * o1[3]));
                    if (MODE == 2) { acc[ai][bj][m][0] = o0; acc[ai][bj][m][1] = o1; }
                    else { u32x4 w; w.x = cvt_pk_bf16(o0[0], o0[1]); w.y = cvt_pk_bf16(o0[2], o0[3]); w.z = cvt_pk_bf16(o1[0], o1[1]); w.w = cvt_pk_bf16(o1[2], o1[3]); *(u32x4*)(hb + off + 32 * bj) = w; } }
                ss += __shfl_xor(ss, 16); ss += __shfl_xor(ss, 32); if (fq == 0) atomicAdd(ssq + row, ss); }
            asm volatile("" ::: "memory"); }
        if (MODE == 2) {
            asm volatile("s_waitcnt vmcnt(0)" ::: "memory");
            unsigned* c = cnt + 64 * u.pm;
            if (fr == 0 && fq == 0) __hip_atomic_fetch_add(c, 1u, __ATOMIC_RELAXED, __HIP_MEMORY_SCOPE_AGENT);
            unsigned spins = 0;
            while (__hip_atomic_load(c, __ATOMIC_RELAXED, __HIP_MEMORY_SCOPE_AGENT) < 32u) { __builtin_amdgcn_s_sleep(2); if (++spins > (1u << 22)) break; }
            asm volatile("" ::: "memory");
            f32x4 gv[2][2];
#pragma unroll
            for (int bj = 0; bj < 2; ++bj)
#pragma unroll
                for (int n = 0; n < 2; ++n) gv[bj][n] = *(const f32x4*)(gfin + col0 + 32 * bj + n * 4);
            float sv[2][4];
#pragma unroll
            for (int ai = 0; ai < 2; ++ai)
#pragma unroll
                for (int m = 0; m < 4; ++m) sv[ai][m] = __hip_atomic_load(ssq + row0 + ai * HALF + m * 16, __ATOMIC_RELAXED, __HIP_MEMORY_SCOPE_AGENT);
#pragma unroll
            for (int ai = 0; ai < 2; ++ai)
#pragma unroll
                for (int m = 0; m < 4; ++m) { const float rs = 1.0f / sqrtf(sv[ai][m] * (1.0f / 1024.0f) + RMS_EPS); const size_t off = (size_t)(row0 + ai * HALF + m * 16) * 1024 + col0;
#pragma unroll
                    for (int bj = 0; bj < 2; ++bj)
#pragma unroll
                        for (int n = 0; n < 2; ++n) *(f32x4*)(out + off + 32 * bj + n * 4) = acc[ai][bj][m][n] * rs * gv[bj][n]; }
        }
    }
};
struct EpiSoftmax {
    static constexpr bool PERM = true, AFTER_DRAIN = true;
    bf16_t* P; float scale_log2e;
    __device__ __forceinline__ void fused(f32x4 (&acc)[2][2][4][2], const Unit& u, int wr, int wc, int fr, int fq, PG8_LAS unsigned char* lds, int wid, int lane) const {
        PG8_LAS float* RM = (PG8_LAS float*)lds;
        PG8_LAS float* RSM = (PG8_LAS float*)(lds + 4096);
#pragma unroll
        for (int ai = 0; ai < 2; ++ai)
#pragma unroll
            for (int m = 0; m < 4; ++m) { float mx = -3.0e38f;
#pragma unroll
                for (int bj = 0; bj < 2; ++bj)
#pragma unroll
                    for (int n = 0; n < 2; ++n) { const f32x4 x = acc[ai][bj][m][n]; mx = fmaxf(mx, fmaxf(fmaxf(x[0], x[1]), fmaxf(x[2], x[3]))); }
                mx = fmaxf(mx, __shfl_xor(mx, 16)); mx = fmaxf(mx, __shfl_xor(mx, 32));
                if (fq == 0) RM[(ai * HALF + wr * 64 + m * 16 + fr) * 4 + wc] = mx; }
        asm volatile("s_waitcnt lgkmcnt(0)" ::: "memory"); __builtin_amdgcn_s_barrier(); asm volatile("" ::: "memory");
#pragma unroll
        for (int ai = 0; ai < 2; ++ai)
#pragma unroll
            for (int m = 0; m < 4; ++m) { const int r = ai * HALF + wr * 64 + m * 16 + fr; const f32x4 m4 = *(const PG8_LAS f32x4*)(RM + r * 4);
                const float gm = fmaxf(fmaxf(m4[0], m4[1]), fmaxf(m4[2], m4[3])); float s = 0.f;
#pragma unroll
                for (int bj = 0; bj < 2; ++bj)
#pragma unroll
                    for (int n = 0; n < 2; ++n) { f32x4 x = acc[ai][bj][m][n];
#pragma unroll
                        for (int j = 0; j < 4; ++j) { x[j] = __builtin_amdgcn_exp2f((x[j] - gm) * scale_log2e); s += x[j]; }
                        acc[ai][bj][m][n] = x; }
                s += __shfl_xor(s, 16); s += __shfl_xor(s, 32);
                if (fq == 0) RSM[r * 4 + wc] = s; }
        asm volatile("s_waitcnt lgkmcnt(0)" ::: "memory"); __builtin_amdgcn_s_barrier(); asm volatile("" ::: "memory");
        const int col0 = wc * 64 + 8 * fq;
#pragma unroll
        for (int ai = 0; ai < 2; ++ai)
#pragma unroll
            for (int m = 0; m < 4; ++m) { const int r = ai * HALF + wr * 64 + m * 16 + fr; const f32x4 s4 = *(const PG8_LAS f32x4*)(RSM + r * 4);
                const float inv = 1.0f / ((s4[0] + s4[1]) + (s4[2] + s4[3])); bf16_t* rowp = P + (size_t)r * 256 + col0;
#pragma unroll
                for (int bj = 0; bj < 2; ++bj) { const f32x4 v0 = acc[ai][bj][m][0] * inv, v1 = acc[ai][bj][m][1] * inv;
                    u32x4 w; w.x = cvt_pk_bf16(v0[0], v0[1]); w.y = cvt_pk_bf16(v0[2], v0[3]); w.z = cvt_pk_bf16(v1[0], v1[1]); w.w = cvt_pk_bf16(v1[2], v1[3]);
                    *(u32x4*)(rowp + 32 * bj) = w; } }
    }
};

struct EpiSoftmaxS {
    static constexpr bool PERM = true, AFTER_DRAIN = false;
    bf16_t* P; float scale_log2e; PG8_LAS unsigned char* tab;
    __device__ __forceinline__ void operator()(f32x4 (&acc)[2][2][4][2], const Unit& u, int wr, int wc, int fr, int fq) const {
        EpiSoftmax E{P + (size_t)u.id * 65536, scale_log2e};
        E.fused(acc, u, wr, wc, fr, fq, tab, 0, 0);
    }
};

template <class Epi, class Sched, bool ALIGN_EPI = false, bool SP2 = false>
__device__ __forceinline__ void gemm_phase(PG8_LAS unsigned char* lds, const Gemm g, const Sched& S, const Epi& E) {
    int tid_ = threadIdx.x; asm volatile("" : "+v"(tid_));
    const int tid = tid_, wid = __builtin_amdgcn_readfirstlane(tid >> 6), lane = tid & 63, wr = wid >> 2, wc = wid & 3, fr = lane & 15, fq = lane >> 4;
    const int K = g.K, nt = K / BK;
    unsigned voffA[2], voffB0[2], voffB1[2];
#pragma unroll
    for (int i = 0; i < 2; ++i) { int R, C; stage_rc(tid * 16 + i * 8192, R, C);
        voffA[i] = (unsigned)(R * g.lda + C) * 2u;
        voffB0[i] = (unsigned)((Epi::PERM ? perm2(0, R) : R) * g.ldb + C) * 2u; voffB1[i] = (unsigned)((Epi::PERM ? perm2(1, R) : HALF + R) * g.ldb + C) * 2u; }
    const size_t kstep = (size_t)(BK * 2);
    const size_t hstepA = (size_t)HALF * g.lda * 2, hstepB = (size_t)HALF * g.ldb * 2;
    const size_t tstepA = g.atstep ? g.atstep : 2 * hstepA, tstepB = 2 * hstepB;
    const size_t kstepA = g.akstep ? g.akstep : kstep;
    const unsigned ldsw = (unsigned)wid * 1024u;
    const int aoff = lds_byte(wr * 64 + fr, fq * 8), boff = lds_byte(wc * 32 + fr, fq * 8);
#define PG8_SA(b, h) (((b) * 2 + (h)) * HTB)
#define PG8_SB(b, h) ((4 + (b) * 2 + (h)) * HTB)
#define PG8_STAGE(bufoff, gbase, voff) do { _Pragma("unroll") for (int _i = 0; _i < 2; ++_i) \
        __builtin_amdgcn_global_load_lds((const unsigned*)((const char*)(gbase) + (voff)[_i]), (PG8_LAS unsigned*)(lds + (bufoff) + ldsw + _i * 8192), 16, 0, 0); } while (0)
#define PG8_LDA(dst, b, h) do { _Pragma("unroll") for (int m = 0; m < 4; ++m) _Pragma("unroll") for (int k = 0; k < 2; ++k) dst[m][k] = *(const PG8_LAS bf16x8*)(lds + PG8_SA(b, h) + aoff + m * 2048 + k * 1024); } while (0)
#define PG8_LDB(dst, b, h) do { _Pragma("unroll") for (int n = 0; n < 2; ++n) _Pragma("unroll") for (int k = 0; k < 2; ++k) dst[n][k] = *(const PG8_LAS bf16x8*)(lds + PG8_SB(b, h) + boff + n * 2048 + k * 1024); } while (0)
#define PG8_MMA(ai, bj, At, Bt) do { __builtin_amdgcn_s_setprio(1); _Pragma("unroll") for (int m = 0; m < 4; ++m) _Pragma("unroll") for (int n = 0; n < 2; ++n) _Pragma("unroll") for (int k = 0; k < 2; ++k) \
        acc[ai][bj][m][n] = __builtin_amdgcn_mfma_f32_16x16x32_bf16(Bt[n][k], At[m][k], acc[ai][bj][m][n], 0, 0, 0); __builtin_amdgcn_s_setprio(0); } while (0)
#define PG8_WAIT_V(n) asm volatile("s_waitcnt vmcnt(" #n ")" ::: "memory")
#define PG8_WAIT_L(n) asm volatile("s_waitcnt lgkmcnt(" #n ")" ::: "memory")
#define PG8_BAR __builtin_amdgcn_s_barrier()
#define PG8_SCHED __builtin_amdgcn_sched_barrier(0)
    Unit cur, nxt; int ui = 0;
    if (!S.next(0, cur)) return;
    f32x4 acc[2][2][4][2];
#pragma unroll
    for (int a = 0; a < 2; ++a)
#pragma unroll
        for (int b = 0; b < 2; ++b)
#pragma unroll
            for (int m = 0; m < 4; ++m)
#pragma unroll
                for (int n = 0; n < 2; ++n) acc[a][b][m][n] = (f32x4){0.f, 0.f, 0.f, 0.f};
    bf16x8 At[4][2], B0[2][2], B1[2][2];
    const char* cA = (const char*)g.A + (size_t)cur.pm * tstepA + cur.ao; const char* cB = (const char*)g.Bt + (size_t)cur.pn * tstepB + cur.bo;
    S.a_ready(cur);
    if constexpr (SP2) {
        PG8_STAGE(PG8_SB(0, 0), cB, voffB0); PG8_STAGE(PG8_SB(0, 1), cB, voffB1); PG8_STAGE(PG8_SA(0, 0), cA, voffA); PG8_STAGE(PG8_SA(0, 1), cA + hstepA, voffA);
        if (wr == 1) PG8_BAR;
        PG8_WAIT_V(2); PG8_BAR;
        PG8_STAGE(PG8_SB(1, 0), cB + kstep, voffB0); PG8_STAGE(PG8_SA(1, 0), cA + kstepA, voffA); PG8_STAGE(PG8_SB(1, 1), cB + kstep, voffB1);
        PG8_WAIT_V(6); PG8_BAR;
    } else {
        PG8_STAGE(PG8_SB(0, 0), cB, voffB0); PG8_STAGE(PG8_SA(0, 0), cA, voffA); PG8_STAGE(PG8_SB(0, 1), cB, voffB1); PG8_STAGE(PG8_SA(0, 1), cA + hstepA, voffA);
        if (wr == 1) PG8_BAR;
        PG8_WAIT_V(4); PG8_BAR;
        PG8_STAGE(PG8_SB(1, 0), cB + kstep, voffB0); PG8_STAGE(PG8_SA(1, 0), cA + kstepA, voffA); PG8_STAGE(PG8_SB(1, 1), cB + kstep, voffB1);
        PG8_WAIT_V(6); PG8_BAR;
    }
    for (;;) {
        const bool has_next = S.next(ui + 1, nxt);
        const char* nA = has_next ? (const char*)g.A + (size_t)nxt.pm * tstepA + nxt.ao : cA; const char* nB = has_next ? (const char*)g.Bt + (size_t)nxt.pn * tstepB + nxt.bo : cB;
#pragma unroll 1
        for (int t = 0; t < nt; t += 2) {
            const bool last = (t == nt - 2);
            const char* a1 = cA + (size_t)(t + 1) * kstepA;
            const char* a2 = last ? nA : cA + (size_t)(t + 2) * kstepA; const char* b2 = last ? nB : cB + (size_t)(t + 2) * kstep;
            const char* a3 = a2 + kstepA; const char* b3 = b2 + kstep;
            if (last && has_next) S.a_ready(nxt);
            if constexpr (SP2) {
            PG8_LDB(B0, 0, 0); PG8_LDB(B1, 0, 1); PG8_SCHED; PG8_LDA(At, 0, 0); PG8_STAGE(PG8_SA(1, 1), a1 + hstepA, voffA);
            PG8_WAIT_V(8); PG8_WAIT_L(0); PG8_BAR; PG8_MMA(0, 0, At, B0); PG8_MMA(0, 1, At, B1); PG8_BAR; PG8_SCHED;
            PG8_LDA(At, 0, 1); PG8_STAGE(PG8_SB(0, 0), b2, voffB0); PG8_STAGE(PG8_SB(0, 1), b2, voffB1); PG8_STAGE(PG8_SA(0, 0), a2, voffA);
            PG8_WAIT_V(8); PG8_WAIT_L(0); PG8_BAR; PG8_MMA(1, 0, At, B0); PG8_MMA(1, 1, At, B1); PG8_BAR; PG8_SCHED;
            PG8_LDB(B0, 1, 0); PG8_LDB(B1, 1, 1); PG8_SCHED; PG8_LDA(At, 1, 0); PG8_STAGE(PG8_SA(0, 1), a2 + hstepA, voffA);
            PG8_WAIT_V(8); PG8_WAIT_L(0); PG8_BAR; PG8_MMA(0, 0, At, B0); PG8_MMA(0, 1, At, B1); PG8_BAR; PG8_SCHED;
            PG8_LDA(At, 1, 1); PG8_STAGE(PG8_SB(1, 0), b3, voffB0); PG8_STAGE(PG8_SB(1, 1), b3, voffB1); PG8_STAGE(PG8_SA(1, 0), a3, voffA);
            PG8_WAIT_V(8); PG8_WAIT_L(0); PG8_BAR; PG8_MMA(1, 0, At, B0); PG8_MMA(1, 1, At, B1); PG8_BAR; PG8_SCHED;
            } else {
            PG8_LDB(B0, 0, 0); PG8_SCHED; PG8_LDA(At, 0, 0); PG8_STAGE(PG8_SA(1, 1), a1 + hstepA, voffA);
            PG8_WAIT_L(8); PG8_BAR; PG8_WAIT_L(0); PG8_MMA(0, 0, At, B0); PG8_BAR; PG8_SCHED;
            PG8_LDB(B1, 0, 1); PG8_STAGE(PG8_SB(0, 0), b2, voffB0);
            PG8_BAR; PG8_WAIT_L(0); PG8_MMA(0, 1, At, B1); PG8_BAR;
            PG8_LDA(At, 0, 1); PG8_STAGE(PG8_SA(0, 0), a2, voffA);
            PG8_BAR; PG8_WAIT_L(0); PG8_MMA(1, 0, At, B0); PG8_BAR; PG8_SCHED;
            PG8_STAGE(PG8_SB(0, 1), b2, voffB1);
            PG8_WAIT_V(6); PG8_BAR; PG8_MMA(1, 1, At, B1); PG8_BAR;
            PG8_LDB(B0, 1, 0); PG8_SCHED; PG8_LDA(At, 1, 0); PG8_STAGE(PG8_SA(0, 1), a2 + hstepA, voffA);
            PG8_WAIT_L(8); PG8_BAR; PG8_WAIT_L(0); PG8_MMA(0, 0, At, B0); PG8_BAR; PG8_SCHED;
            PG8_LDB(B1, 1, 1); PG8_STAGE(PG8_SB(1, 0), b3, voffB0);
            PG8_BAR; PG8_WAIT_L(0); PG8_MMA(0, 1, At, B1); PG8_BAR;
            PG8_LDA(At, 1, 1); PG8_STAGE(PG8_SA(1, 0), a3, voffA);
            PG8_BAR; PG8_WAIT_L(0); PG8_MMA(1, 0, At, B0); PG8_BAR; PG8_SCHED;
            PG8_STAGE(PG8_SB(1, 1), b3, voffB1);
            PG8_WAIT_V(6); PG8_BAR; PG8_MMA(1, 1, At, B1); PG8_BAR;
            }
        }
        if constexpr (ALIGN_EPI) { if (wr == 0) PG8_BAR; }
        if constexpr (!Epi::AFTER_DRAIN) { E(acc, cur, wr, wc, fr, fq); S.done(cur); }
        if (!has_next) break;
#pragma unroll
        for (int a = 0; a < 2; ++a)
#pragma unroll
            for (int b = 0; b < 2; ++b)
#pragma unroll
                for (int m = 0; m < 4; ++m)
#pragma unroll
                    for (int n = 0; n < 2; ++n) acc[a][b][m][n] = (f32x4){0.f, 0.f, 0.f, 0.f};
        cur = nxt; cA = nA; cB = nB; ++ui;
        if constexpr (ALIGN_EPI) { if (wr == 1) PG8_BAR; }
    }
    PG8_WAIT_V(0);
    if constexpr (!ALIGN_EPI) { if (wr == 0) PG8_BAR; }
    PG8_BAR;
    if constexpr (Epi::AFTER_DRAIN) { E.fused(acc, cur, wr, wc, fr, fq, lds, wid, lane); S.done(cur); }
#undef PG8_SA
#undef PG8_SB
#undef PG8_STAGE
#undef PG8_LDA
#undef PG8_LDB
#undef PG8_MMA
#undef PG8_WAIT_V
#undef PG8_WAIT_L
#undef PG8_BAR
#undef PG8_SCHED
}
}

constexpr int NWAVES = 8;
constexpr int N_LAUNCHES = MK_N_LAUNCHES;
constexpr int N_PHASES = 11;
constexpr int BATCH = 16, SEQ = 2048, D = 1024, M = BATCH * SEQ;
constexpr int NPROJ = 2560, INCOLS = 2568, MEML = 256, MROWS = BATCH * MEML, FF = 4096;
constexpr int DNW = 512, DNH = 4, DNHD = 128, CHUNK = 64;

constexpr size_t MiB = 1u << 20;
constexpr size_t WS_CTL = 0, CTL_ZERO_BYTES = 1 * MiB;
constexpr size_t WS_BA = 1 * MiB;
constexpr size_t WS_SSQ1 = 256 * 1024, WS_SSQ2 = 512 * 1024, WS_SSQ3 = 768 * 1024, WS_CNT3 = 896 * 1024;
constexpr size_t WS_WIN = 8 * MiB, WS_WOUT = 13 * MiB, WS_WQ = 15 * MiB, WS_WK = 17 * MiB, WS_WV = 19 * MiB, WS_WO = 21 * MiB, WS_WUP = 23 * MiB, WS_WDN = 31 * MiB;
constexpr size_t WS_MN = 40 * MiB, WS_KM = 48 * MiB, WS_VT = 56 * MiB;
constexpr size_t WS_A = 64 * MiB;
constexpr size_t WS_SSQ0 = 2 * MiB;
constexpr size_t WS_Y = 352 * MiB;
constexpr size_t WS_B = 128 * MiB;
constexpr size_t WS_C = 192 * MiB;
constexpr size_t WS_PS = 256 * MiB;
constexpr size_t WS_OR = 128 * MiB;
constexpr size_t WS_GWM = 352 * MiB, WS_GUT = 384 * MiB, WS_GQG = 416 * MiB, WS_GKD = 448 * MiB, WS_GAM = 480 * MiB, WS_GGL = 496 * MiB;
constexpr size_t WS_END = 497 * MiB;
constexpr int CW_BAR = 4096;

constexpr int RING_BYTES = 131072;
constexpr int LDS_BYTES = 147456;
constexpr int LDSCTL_OFF = LDS_BYTES - 512, MISC_OFF = LDSCTL_OFF + 320;

#define GAS __attribute__((address_space(1)))
#define LAS __attribute__((address_space(3)))
typedef unsigned short bf16;
typedef unsigned v4u __attribute__((ext_vector_type(4)));
typedef unsigned v2u __attribute__((ext_vector_type(2)));
typedef float f32x4 __attribute__((ext_vector_type(4)));
typedef GAS unsigned gu32;
#define LDS_WAIT() asm volatile("s_waitcnt lgkmcnt(0)" ::: "memory")
#define VM_WAIT() asm volatile("s_waitcnt vmcnt(0)" ::: "memory")
typedef float f32x2_t __attribute__((ext_vector_type(2)));
typedef __bf16 bf16x2_t __attribute__((ext_vector_type(2)));
__device__ __forceinline__ unsigned pk2(float lo, float hi) { const f32x2_t v = {lo, hi}; const bf16x2_t b = __builtin_convertvector(v, bf16x2_t); return __builtin_bit_cast(unsigned, b); }
__device__ __forceinline__ unsigned f2bf(float f) { return pk2(f, 0.f) & 0xffffu; }
__device__ __forceinline__ float bflo(unsigned w) { return __builtin_bit_cast(float, w << 16); }
__device__ __forceinline__ float bfhi(unsigned w) { return __builtin_bit_cast(float, w & 0xffff0000u); }
__device__ __forceinline__ void unpack8(const v4u w, float (&f)[8]) { f[0] = bflo(w.x); f[1] = bfhi(w.x); f[2] = bflo(w.y); f[3] = bfhi(w.y); f[4] = bflo(w.z); f[5] = bfhi(w.z); f[6] = bflo(w.w); f[7] = bfhi(w.w); }

#define XB_TMO      128
#define XB_XCNT(j)  (256  + 64 * (j))
#define XB_XSUB(j)  (1280 + 64 * (j))
#define XB_XGEN(j)  (2304 + 64 * (j))
#define XB_TOP      3328
#define XB_TOPGEN   3392
#define XCD_BAR_WORDS 3456
#define XB_SPIN_CAP (1u << 18)
__device__ __forceinline__ unsigned xb_ld(unsigned* p)              { return __hip_atomic_load(p, __ATOMIC_RELAXED, __HIP_MEMORY_SCOPE_AGENT); }
__device__ __forceinline__ unsigned xb_add(unsigned* p, unsigned v) { return __hip_atomic_fetch_add(p, v, __ATOMIC_RELAXED, __HIP_MEMORY_SCOPE_AGENT); }
__device__ __forceinline__ unsigned xb_xcc_id() { return (unsigned)__builtin_amdgcn_s_getreg((3 << 11) | 20) & 0xFu; }
#define XB_SPIN(cond, bar) do { unsigned _sp = 0; while (cond) { __builtin_amdgcn_s_sleep(1); \
    if ((++_sp & 255u) == 0u) { if (xb_ld(&(bar)[XB_TMO])) break; if (_sp > XB_SPIN_CAP) { atomicAdd(&(bar)[XB_TMO], 1u); break; } } } } while (0)
struct XcdBarrier { unsigned* bar; unsigned x; volatile LAS unsigned* st; };
__device__ __forceinline__ XcdBarrier xcd_barrier_post(unsigned* bar, volatile LAS unsigned* st) {
    XcdBarrier b; b.bar = bar; b.x = xb_xcc_id(); b.st = st;
    if (threadIdx.x == 0) (void)xb_add(&bar[XB_XCNT(b.x)], 1u);
    return b;
}
__device__ __forceinline__ void xcd_barrier_complete(unsigned* bar, unsigned x, unsigned& nloc, unsigned& nx) {
    const unsigned G = gridDim.x * gridDim.y * gridDim.z;
    unsigned sum, cnt, mine, sp = 0u;
    for (;;) {
        sum = 0u; cnt = 0u; mine = 0u;
#pragma unroll
        for (unsigned j = 0; j < 16; ++j) { const unsigned c = xb_ld(&bar[XB_XCNT(j)]); sum += c; cnt += (c > 0u) ? 1u : 0u; mine = (j == x) ? c : mine; }
        if (sum == G) break;
        __builtin_amdgcn_s_sleep(1);
        if ((++sp & 255u) == 0u) { if (xb_ld(&bar[XB_TMO])) break; if (sp > XB_SPIN_CAP) { atomicAdd(&bar[XB_TMO], 1u); break; } }
    }
    nloc = mine > 0u ? mine : 1u; nx = cnt > 0u ? cnt : 1u;
}
__device__ __forceinline__ void xcd_barrier(const XcdBarrier& b) {
    asm volatile("s_waitcnt vmcnt(0)" ::: "memory");
    __syncthreads();
    if (threadIdx.x == 0) {
        unsigned* bar = b.bar;
        __builtin_amdgcn_s_waitcnt(0);
        unsigned nloc = b.st[0], nx = b.st[1];
        if (nloc == 0u) { xcd_barrier_complete(bar, b.x, nloc, nx); b.st[0] = nloc; b.st[1] = nx; }
        const unsigned old = xb_add(&bar[XB_XSUB(b.x)], 1u);
        const unsigned gen = old / nloc;
        if (old + 1u == (gen + 1u) * nloc) {
            __builtin_amdgcn_fence(__ATOMIC_RELEASE, "agent");
            asm volatile("s_waitcnt vmcnt(0)" ::: "memory");
            const unsigned og = xb_add(&bar[XB_TOP], 1u);
            const unsigned tg = og / nx;
            if (og + 1u == (tg + 1u) * nx) xb_add(&bar[XB_TOPGEN], 1u);
            else XB_SPIN(xb_ld(&bar[XB_TOPGEN]) == tg, bar);
            __builtin_amdgcn_fence(__ATOMIC_ACQUIRE, "agent");
            xb_add(&bar[XB_XGEN(b.x)], 1u);
            asm volatile("s_waitcnt vmcnt(0)" ::: "memory");
        } else {
            XB_SPIN(xb_ld(&bar[XB_XGEN(b.x)]) == gen, bar);
            __builtin_amdgcn_fence(__ATOMIC_ACQUIRE, "agent");
            asm volatile("s_waitcnt vmcnt(0)" ::: "memory");
        }
    }
    __syncthreads();
}


__device__ __forceinline__ float dppf(float v, const int ctrl_sel) {
    const int x = __builtin_bit_cast(int, v); int r;
    if (ctrl_sel == 0) r = __builtin_amdgcn_update_dpp(0, x, 0xB1, 0xF, 0xF, true);
    else if (ctrl_sel == 1) r = __builtin_amdgcn_update_dpp(0, x, 0x4E, 0xF, 0xF, true);
    else if (ctrl_sel == 2) r = __builtin_amdgcn_update_dpp(0, x, 0x141, 0xF, 0xF, true);
    else r = __builtin_amdgcn_update_dpp(0, x, 0x140, 0xF, 0xF, true);
    return __builtin_bit_cast(float, r);
}
__device__ __forceinline__ float row16_sum(float v) {
    v += dppf(v, 0); v += dppf(v, 1); v += dppf(v, 2); v += dppf(v, 3); return v;
}
__device__ __forceinline__ float wave_sum(float v) {
    v = row16_sum(v);
    const int x = __builtin_bit_cast(int, v);
    const float a = __builtin_bit_cast(float, __builtin_amdgcn_readlane(x, 0)), b = __builtin_bit_cast(float, __builtin_amdgcn_readlane(x, 16));
    const float c = __builtin_bit_cast(float, __builtin_amdgcn_readlane(x, 32)), d = __builtin_bit_cast(float, __builtin_amdgcn_readlane(x, 48));
    return (a + b) + (c + d);
}
__device__ __forceinline__ float silu_f(float x) { return x * __builtin_amdgcn_rcpf(1.0f + __expf(-x)); }

#define PHASE_TID() int tid_ = threadIdx.x; asm volatile("" : "+v"(tid_)); const int tid = tid_, lane = tid & 63, wave = __builtin_amdgcn_readfirstlane(tid >> 6); (void)lane; (void)wave
struct Ctx {
    LAS unsigned char* lds;
    int vcu, G;
    const float *x, *mem, *g_mix, *w_in, *w_pool, *pool_scale, *conv_w, *a_log, *dt_bias, *g_dn, *w_out, *g_xa, *g_mem, *w_xq, *w_xk, *w_xv, *w_xo, *g_mlp, *w_up, *w_down, *g_fin;
    float* out; unsigned char* ws;
};

__device__ __forceinline__ void transpose_item(const float* W, int ldw, int nblk, const float* kscale, bf16* WT, int ldt, int koff, LAS float* scr, int item, int lane) {
    const int kb = item / nblk, nb = item % nblk, k0 = 64 * kb, n0 = 32 * nb;
    f32x4 wv[8];
#pragma unroll
    for (int i = 0; i < 8; ++i) wv[i] = __builtin_nontemporal_load((const f32x4*)(W + (size_t)(k0 + (lane >> 3) + 8 * i) * ldw + n0 + 4 * (lane & 7)));
#pragma unroll
    for (int i = 0; i < 8; ++i) { const int kk = (lane >> 3) + 8 * i; f32x4 v = wv[i]; if (kscale) v = v * kscale[k0 + kk];
        LAS float* d = scr + kk * 33 + 4 * (lane & 7); d[0] = v[0]; d[1] = v[1]; d[2] = v[2]; d[3] = v[3]; }
    LDS_WAIT(); asm volatile("" ::: "memory");
    const int c = lane & 7;
#pragma unroll
    for (int j = 0; j < 4; ++j) { const int n = (lane >> 3) + 8 * j; const LAS float* s = scr + (8 * c) * 33 + n;
        v4u o; o.x = pk2(s[0 * 33], s[1 * 33]); o.y = pk2(s[2 * 33], s[3 * 33]); o.z = pk2(s[4 * 33], s[5 * 33]); o.w = pk2(s[6 * 33], s[7 * 33]);
        *(GAS v4u*)(WT + (size_t)(n0 + n) * ldt + koff + k0 + 8 * c) = o; }
    LDS_WAIT(); asm volatile("" ::: "memory");
}

__device__ __forceinline__ void late_weight_copies(const Ctx& F, int wgi, int nwg) {
    PHASE_TID();
    LAS float* scr = (LAS float*)(F.lds + wave * 16384);
    bf16* WQ = (bf16*)(F.ws + WS_WQ); bf16* WO = (bf16*)(F.ws + WS_WO); bf16* WUP = (bf16*)(F.ws + WS_WUP); bf16* WDN = (bf16*)(F.ws + WS_WDN);
    constexpr int I_SQ = 16 * 32, I_UP = 16 * 128, I_DN = 64 * 32, NITEMS = 2 * I_SQ + I_UP + I_DN;
    for (int it = wgi * NWAVES + wave; it < NITEMS; it += nwg * NWAVES) {
        int r = it;
        if (r < I_SQ) { transpose_item(F.w_xq, 1024, 32, F.g_xa, WQ, 1024, 0, scr, r, lane); continue; } r -= I_SQ;
        if (r < I_SQ) { transpose_item(F.w_xo, 1024, 32, nullptr, WO, 1024, 0, scr, r, lane); continue; } r -= I_SQ;
        if (r < I_UP) { transpose_item(F.w_up, 4096, 128, F.g_mlp, WUP, 1024, 0, scr, r, lane); continue; } r -= I_UP;
        transpose_item(F.w_down, 1024, 32, nullptr, WDN, 4096, 0, scr, r, lane);
    }
}

__device__ __forceinline__ void p0_prologue(const Ctx& F) {
    PHASE_TID();
    LAS float* scr = (LAS float*)(F.lds + wave * 16384);
    const int gw = F.vcu * NWAVES + wave, NGW = F.G * NWAVES;
    bf16* WIN = (bf16*)(F.ws + WS_WIN); bf16* WOUT = (bf16*)(F.ws + WS_WOUT); bf16* WK = (bf16*)(F.ws + WS_WK);
    bf16* WV = (bf16*)(F.ws + WS_WV);
    constexpr int I_IN = 16 * 80, I_OUT = 8 * 32, I_SQ = 16 * 32;
    constexpr int NITEMS = I_IN + I_OUT + 2 * I_SQ;
    for (int it = gw; it < NITEMS; it += NGW) {
        int r = it;
        if (r < I_IN) { transpose_item(F.w_in, INCOLS, 80, F.g_mix, WIN, 1024, 0, scr, r, lane); continue; } r -= I_IN;
        if (r < I_OUT) { transpose_item(F.w_out + (size_t)512 * 1024, 1024, 32, nullptr, WOUT, 1024, 512, scr, r, lane); continue; } r -= I_OUT;
        if (r < I_SQ) { transpose_item(F.w_xk, 1024, 32, nullptr, WK, 1024, 0, scr, r, lane); continue; } r -= I_SQ;
        transpose_item(F.w_xv, 1024, 32, nullptr, WV, 1024, 0, scr, r, lane);
    }
    for (int it = (F.vcu * NWAVES * 64) + tid; it < 1024 * 64; it += F.G * NWAVES * 64) {
        const int n = it & 1023, k8 = it >> 10, g = k8 >> 4, c0 = (k8 & 15) * 8;
        float acc[8];
#pragma unroll
        for (int j = 0; j < 8; ++j) acc[j] = 0.f;
        const float* wp = F.w_pool + (size_t)(g * 128 + c0) * 128;
        for (int d = 0; d < 128; ++d) { const float wo = F.w_out[(size_t)(g * 128 + d) * 1024 + n] * F.pool_scale[g * 128 + d];
#pragma unroll
            for (int j = 0; j < 8; ++j) acc[j] += wp[j * 128 + d] * wo; }
        v4u o; o.x = pk2(acc[0], acc[1]); o.y = pk2(acc[2], acc[3]); o.z = pk2(acc[4], acc[5]); o.w = pk2(acc[6], acc[7]);
        *(GAS v4u*)(WOUT + (size_t)n * 1024 + g * 128 + c0) = o;
    }
    {
        float wba[16][8];
#pragma unroll
        for (int j = 0; j < 4; ++j)
#pragma unroll
            for (int i = 0; i < 4; ++i) { const int k = 4 * lane + 256 * j + i; const f32x4* p = (const f32x4*)(F.w_in + (size_t)k * INCOLS + NPROJ); const f32x4 a = p[0], b = p[1];
                wba[j * 4 + i][0] = a[0]; wba[j * 4 + i][1] = a[1]; wba[j * 4 + i][2] = a[2]; wba[j * 4 + i][3] = a[3]; wba[j * 4 + i][4] = b[0]; wba[j * 4 + i][5] = b[1]; wba[j * 4 + i][6] = b[2]; wba[j * 4 + i][7] = b[3]; }
        f32x4 gv[4];
#pragma unroll
        for (int j = 0; j < 4; ++j) gv[j] = ((const f32x4*)F.g_mix)[lane + 64 * j];
        bf16* XN = (bf16*)(F.ws + WS_A); float* BA = (float*)(F.ws + WS_BA);
        for (int m = gw; m < M; m += NGW) {
            const GAS f32x4* xr = (const GAS f32x4*)(F.x + (size_t)m * D) + lane;
            f32x4 v[4]; float s = 0.f;
#pragma unroll
            for (int j = 0; j < 4; ++j) { v[j] = __builtin_nontemporal_load(xr + 64 * j); s += (v[j][0] * v[j][0] + v[j][1] * v[j][1]) + (v[j][2] * v[j][2] + v[j][3] * v[j][3]); }
            const float ssx = wave_sum(s);
            const float rs = 1.0f / sqrtf(ssx * (1.0f / D) + pg8::RMS_EPS);
            GAS unsigned long long* o8 = (GAS unsigned long long*)(XN + (size_t)m * D) + lane;
            float dsum[8];
#pragma unroll
            for (int c = 0; c < 8; ++c) dsum[c] = 0.f;
#pragma unroll
            for (int j = 0; j < 4; ++j) {
                o8[64 * j] = (unsigned long long)pk2(v[j][0], v[j][1]) | ((unsigned long long)pk2(v[j][2], v[j][3]) << 32);
                v[j] = v[j] * rs * gv[j];
#pragma unroll
                for (int i = 0; i < 4; ++i)
#pragma unroll
                    for (int c = 0; c < 8; ++c) dsum[c] += v[j][i] * wba[j * 4 + i][c]; }
#pragma unroll
            for (int c = 0; c < 8; ++c) dsum[c] = wave_sum(dsum[c]);
            if (lane == 0) { ((float*)(F.ws + WS_SSQ0))[m] = ssx; *(GAS f32x4*)(BA + (size_t)m * 8) = (f32x4){dsum[0], dsum[1], dsum[2], dsum[3]}; *(GAS f32x4*)(BA + (size_t)m * 8 + 4) = (f32x4){dsum[4], dsum[5], dsum[6], dsum[7]}; }
        }
    }
    {
        f32x4 gv[4];
#pragma unroll
        for (int j = 0; j < 4; ++j) gv[j] = ((const f32x4*)F.g_mem)[lane + 64 * j];
        bf16* MN = (bf16*)(F.ws + WS_MN);
        for (int m = gw; m < MROWS; m += NGW) {
            const GAS f32x4* xr = (const GAS f32x4*)(F.mem + (size_t)m * D) + lane;
            f32x4 v[4]; float s = 0.f;
#pragma unroll
            for (int j = 0; j < 4; ++j) { v[j] = __builtin_nontemporal_load(xr + 64 * j); s += (v[j][0] * v[j][0] + v[j][1] * v[j][1]) + (v[j][2] * v[j][2] + v[j][3] * v[j][3]); }
            const float rs = 1.0f / sqrtf(wave_sum(s) * (1.0f / D) + pg8::RMS_EPS);
            GAS unsigned long long* o8 = (GAS unsigned long long*)(MN + (size_t)m * D) + lane;
#pragma unroll
            for (int j = 0; j < 4; ++j) { v[j] = v[j] * rs * gv[j]; o8[64 * j] = (unsigned long long)pk2(v[j][0], v[j][1]) | ((unsigned long long)pk2(v[j][2], v[j][3]) << 32); }
        }
    }
}

typedef short bf16x8v __attribute__((ext_vector_type(8)));
__device__ __forceinline__ f32x4 mfma16(bf16x8v x, bf16x8v y, f32x4 c) { return __builtin_amdgcn_mfma_f32_16x16x32_bf16(x, y, c, 0, 0, 0); }
constexpr int GA_QB = 0, GA_KB = 17408, GA_VB = 34816, GA_LM = 51200, GA_GC = 67584, GA_BT = GA_GC + 256, GA_EG = GA_BT + 256, GA_ED = GA_EG + 256;
constexpr int GA_SZ = GA_ED + 256;
constexpr int GQS = 136;
__device__ __forceinline__ v4u pack8(const float (&f)[8]) { v4u o; o.x = pk2(f[0], f[1]); o.y = pk2(f[2], f[3]); o.z = pk2(f[4], f[5]); o.w = pk2(f[6], f[7]); return o; }
__device__ __forceinline__ float bf2f(unsigned short h) { return __builtin_bit_cast(float, (unsigned)h << 16); }

template <int J, int H> struct SubHalf { static constexpr int G0 = (J + 1) >> 2, GLO = H ? (G0 > 8 ? G0 : 8) : (G0 < 8 ? G0 : 8), GHI = H ? 16 : 8, N = GHI - GLO; };
template <int J, int H> __device__ __forceinline__ void subst_load(f32x4 (&l)[8], const LAS float* LTv) {
    if constexpr (J < 63) {
        using P = SubHalf<J, H>;
#pragma unroll
        for (int g = 0; g < P::N; ++g) l[g] = *(const LAS f32x4*)(LTv + J * 64 + 4 * (P::GLO + g));
    }
}
typedef float f32x2v_ __attribute__((ext_vector_type(2)));
template <int J, int H> __device__ __forceinline__ void subst_fma(f32x2v_ (&R)[64], const f32x4 (&l)[8], const f32x2v_ x) {
    using P = SubHalf<J, H>;
#pragma unroll
    for (int g = 0; g < P::N; ++g)
#pragma unroll
        for (int e = 0; e < 4; ++e) { const int i = 4 * (P::GLO + g) + e; if (i > J) { const float lv = l[g][e]; R[i] = __builtin_elementwise_fma((f32x2v_){-lv, -lv}, x, R[i]); } }
}
template <int J> __device__ __forceinline__ void subst_step(f32x2v_ (&R)[64], f32x4 (&la)[8], f32x4 (&lb)[8], const LAS float* LTv) {
    const f32x2v_ x = R[J];
    subst_load<J, 1>(lb, LTv);
    subst_fma<J, 0>(R, la, x);
    __builtin_amdgcn_sched_barrier(0);
    subst_load<J + 1, 0>(la, LTv);
    subst_fma<J, 1>(R, lb, x);
    __builtin_amdgcn_sched_barrier(0);
}
template <int... Js> __device__ __forceinline__ void subst_all(f32x2v_ (&R)[64], f32x4 (&la)[8], f32x4 (&lb)[8], const LAS float* LTv, std::integer_sequence<int, Js...>) {
    (subst_step<Js>(R, la, lb, LTv), ...);
}

constexpr int GA_TB = 2 * GA_SZ;
static_assert(GA_TB + 4096 <= LDSCTL_OFF, "P2a LDS map");
__device__ __forceinline__ void p2a_tables(const Ctx& F, int pr, int tboff, int t128, const float* BA, float* GL) {
    if (t128 >= 0 && t128 < 128) {
        const int ch0 = 2 * pr, bh = ch0 >> 5, chunk0 = ch0 & 31, b = bh >> 2, h = bh & 3, p = t128 >> 6, t = t128 & 63;
        const size_t row0 = (size_t)b * SEQ + chunk0 * CHUNK;
        LAS float* gcs = (LAS float*)(F.lds + tboff + p * 1024);
        const float bb = BA[(row0 + t128) * 8 + h], aa = BA[(row0 + t128) * 8 + 4 + h] + F.dt_bias[h];
        const float sp = aa > 20.f ? aa : __logf(1.0f + __expf(aa));
        float gc = -__expf(F.a_log[h]) * sp;
#pragma unroll
        for (int o = 1; o < 64; o <<= 1) { const float tt = __builtin_bit_cast(float, __builtin_amdgcn_ds_bpermute(((t - o) & 63) << 2, __builtin_bit_cast(int, gc))); if (t >= o) gc += tt; }
        const float g63 = __builtin_bit_cast(float, __builtin_amdgcn_readlane(__builtin_bit_cast(int, gc), 63));
        gcs[t] = gc; gcs[64 + t] = 1.0f / (1.0f + __expf(-bb)); gcs[128 + t] = __expf(gc); gcs[192 + t] = __expf(g63 - gc);
        if (t == 63) GL[ch0 + p] = __expf(gc);
    }
}

#define P2A_LBAR() do { asm volatile("s_waitcnt lgkmcnt(0)" ::: "memory"); __builtin_amdgcn_s_barrier(); asm volatile("" ::: "memory"); } while (0)
__device__ __forceinline__ void p2a_prep_block(const Ctx& F, const int pr, const int tboff, const int tbk, const int cg, const bf16* PROJ, bf16* QG) {
    const int ch0 = 2 * pr, bh = ch0 >> 5, chunk0 = ch0 & 31, b = bh >> 2, h = bh & 3;
    const size_t row0 = (size_t)b * SEQ + chunk0 * CHUNK;
    const int p = tbk >> 4, tl0 = (4 * tbk) & 63, tok0 = chunk0 * CHUNK + 4 * tbk; const size_t rowb = row0 + 4 * tbk;
    LAS bf16* Qb = (LAS bf16*)(F.lds + p * GA_SZ + GA_QB); LAS bf16* Kb = (LAS bf16*)(F.lds + p * GA_SZ + GA_KB); LAS bf16* Vb = (LAS bf16*)(F.lds + p * GA_SZ + GA_VB);
    const LAS float* egs = (const LAS float*)(F.lds + tboff + p * 1024 + 512);
    v4u raw[3][7];
#pragma unroll
    for (int ty = 0; ty < 3; ++ty)
#pragma unroll
        for (int r = 0; r < 7; ++r) { const bool ok = tok0 - 3 + r >= 0; const size_t rr = ok ? rowb - 3 + r : rowb;
            v4u w = __builtin_nontemporal_load((const GAS v4u*)(PROJ + rr * NPROJ + 512 + 512 * ty + h * 128 + cg * 8));
            if (!ok) w = (v4u){0u, 0u, 0u, 0u};
            raw[ty][r] = w; }
    __builtin_amdgcn_sched_barrier(0);
    v4u qgp[4];
#pragma unroll
    for (int ty = 0; ty < 3; ++ty) {
        float wt[4][8], res[4][8];
#pragma unroll
        for (int i = 0; i < 4; ++i) { const f32x4* pw = (const f32x4*)(F.conv_w + (size_t)i * 1536 + 512 * ty + h * 128 + cg * 8); const f32x4 a0 = pw[0], a1 = pw[1];
#pragma unroll
            for (int e = 0; e < 4; ++e) { wt[i][e] = a0[e]; wt[i][4 + e] = a1[e]; } }
#pragma unroll
        for (int e = 0; e < 4; ++e)
#pragma unroll
            for (int c = 0; c < 8; ++c) res[e][c] = 0.f;
#pragma unroll
        for (int r = 0; r < 7; ++r) { float f[8]; unpack8(raw[ty][r], f);
#pragma unroll
            for (int e = 0; e < 4; ++e) { const int i = r - e; if (i >= 0 && i < 4) {
#pragma unroll
                    for (int c = 0; c < 8; ++c) res[e][c] += wt[i][c] * f[c]; } } }
#pragma unroll
        for (int e = 0; e < 4; ++e) { const int t = tl0 + e;
            float ss = 0.f;
#pragma unroll
            for (int c = 0; c < 8; ++c) { res[e][c] = silu_f(res[e][c]); ss += res[e][c] * res[e][c]; }
            if (ty == 0) { ss = row16_sum(ss); const float rq = (1.0f / sqrtf(ss + 1e-6f)) * 0.08838834764831845f, eg = egs[t]; float qg[8];
#pragma unroll
                for (int c = 0; c < 8; ++c) { res[e][c] *= rq; qg[c] = res[e][c] * eg; }
                *(LAS v4u*)(Qb + t * GQS + cg * 8) = pack8(res[e]); qgp[e] = pack8(qg); }
            else if (ty == 1) { ss = row16_sum(ss); const float rk = 1.0f / sqrtf(ss + 1e-6f);
#pragma unroll
                for (int c = 0; c < 8; ++c) res[e][c] *= rk;
                *(LAS v4u*)(Kb + t * GQS + cg * 8) = pack8(res[e]); }
            else *(LAS v4u*)(Vb + t * 128 + cg * 8) = pack8(res[e]);
        }
    }
#pragma unroll
    for (int e = 0; e < 4; ++e) *(GAS v4u*)(QG + (size_t)(ch0 + p) * 8192 + (tl0 + e) * 128 + cg * 8) = qgp[e];
}
__device__ __forceinline__ void p2a_tiles(const Ctx& F, const int pr, const int tboff, const int wave, const int r16, const int q4, bf16* AM) {
    const int ch0 = 2 * pr;
    for (int job = wave; job < 20; job += NWAVES) {
        const int p = job >= 10 ? 1 : 0, idx = job - 10 * p;
        const LAS bf16* Qb = (const LAS bf16*)(F.lds + p * GA_SZ + GA_QB); const LAS bf16* Kb = (const LAS bf16*)(F.lds + p * GA_SZ + GA_KB);
        LAS float* LT = (LAS float*)(F.lds + p * GA_SZ + GA_LM); const LAS float* gcs = (const LAS float*)(F.lds + tboff + p * 1024); const LAS float* bts = gcs + 64;
        const int ti = idx < 1 ? 0 : (idx < 3 ? 1 : (idx < 6 ? 2 : 3)), tj = idx - (ti * (ti + 1)) / 2;
        f32x4 accL = (f32x4){0.f, 0.f, 0.f, 0.f}, accA = accL;
#pragma unroll
        for (int s = 0; s < 4; ++s) { const bf16x8v ki = *(const LAS bf16x8v*)(Kb + (16 * ti + r16) * GQS + 32 * s + 8 * q4); const bf16x8v kj = *(const LAS bf16x8v*)(Kb + (16 * tj + r16) * GQS + 32 * s + 8 * q4);
            const bf16x8v qi = *(const LAS bf16x8v*)(Qb + (16 * ti + r16) * GQS + 32 * s + 8 * q4);
            accL = mfma16(ki, kj, accL);
            accA = mfma16(kj, qi, accA); }
        { const int j = 16 * tj + r16, i0 = 16 * ti + 4 * q4; const float gj = gcs[j];
          float val[4];
#pragma unroll
          for (int r = 0; r < 4; ++r) { const int i = i0 + r; const float e = __expf(fminf(gcs[i] - gj, 0.f)); val[r] = (j < i) ? bts[i] * accL[r] * e : 0.f; }
          *(LAS f32x4*)(LT + j * 64 + i0) = (f32x4){val[0], val[1], val[2], val[3]}; }
        { const int i = 16 * ti + r16, j0 = 16 * tj + 4 * q4; const float gi = gcs[i];
          float val[4];
#pragma unroll
          for (int r = 0; r < 4; ++r) { const int j = j0 + r; const float e = __expf(fminf(gi - gcs[j], 0.f)); val[r] = (j <= i) ? accA[r] * e : 0.f; }
          v2u w; w.x = pk2(val[0], val[1]); w.y = pk2(val[2], val[3]); *(GAS v2u*)(AM + (size_t)(ch0 + p) * 4096 + i * 64 + j0) = w; }
    }
    for (int job = NWAVES - 1 - wave; job < 12; job += NWAVES) {
        const int p = job >= 6 ? 1 : 0, u = job - 6 * p;
        const int ti = u < 3 ? 0 : (u < 5 ? 1 : 2), tj = u < 3 ? u + 1 : (u < 5 ? u - 1 : 3);
        *(GAS v2u*)(AM + (size_t)(ch0 + p) * 4096 + (16 * ti + r16) * 64 + 16 * tj + 4 * q4) = (v2u){0u, 0u};
    }
}

__device__ __forceinline__ void p2a_gdn_chunks(const Ctx& F) {
    PHASE_TID();
#define P2A_WS(name) unsigned char* name = F.ws; asm volatile("" : "+s"(name))
    constexpr int NPAIR = BATCH * DNH * (SEQ / CHUNK) / 2;
    const int tid0 = tid;
    const bool solver = wave < 4;
    if (F.vcu >= NPAIR) return;
    { P2A_WS(w0); p2a_tables(F, F.vcu, GA_TB, tid0, (const float*)(w0 + WS_BA), (float*)(w0 + WS_GGL)); }
    __syncthreads();
    { P2A_WS(w0); int tl_ = tid0; asm volatile("" : "+v"(tl_)); p2a_prep_block(F, F.vcu, GA_TB, tl_ >> 4, tl_ & 15, (const bf16*)(w0 + WS_C), (bf16*)(w0 + WS_GQG)); }
    __syncthreads();
    { P2A_WS(w0); int tl_ = tid0; asm volatile("" : "+v"(tl_)); p2a_tiles(F, F.vcu, GA_TB, wave, tl_ & 15, (tl_ & 63) >> 4, (bf16*)(w0 + WS_GAM)); }
    __syncthreads();
    int itn = 0;
    for (int pr = F.vcu; pr < NPAIR; pr += F.G, ++itn) {
        const int tb_off = GA_TB + (itn & 1) * 2048, tb_nxt = GA_TB + ((itn + 1) & 1) * 2048;
        const bool has_next = pr + F.G < NPAIR;
        const int ch0 = 2 * pr;
        int t3_ = tid0; asm volatile("" : "+v"(t3_));
        if (solver) {
            const int p = t3_ >> 7, c = t3_ & 127;
            const LAS bf16* Kb = (const LAS bf16*)(F.lds + p * GA_SZ + GA_KB); const LAS bf16* Vb = (const LAS bf16*)(F.lds + p * GA_SZ + GA_VB);
            LAS bf16* Wl = (LAS bf16*)(F.lds + p * GA_SZ + GA_LM);
            unsigned lmv = (unsigned)(size_t)(F.lds + p * GA_SZ + GA_LM), gcv = (unsigned)(size_t)(F.lds + tb_off + p * 1024); asm volatile("" : "+v"(lmv), "+v"(gcv));
            const LAS float* LTv = (const LAS float*)lmv; const LAS float* btv = (const LAS float*)(gcv + 256); const LAS float* egv = (const LAS float*)(gcv + 512); const LAS float* edv = (const LAS float*)(gcv + 768);
            const size_t chp = (size_t)(ch0 + p);
            P2A_WS(w1); bf16* KDT = (bf16*)(w1 + WS_GKD);
            f32x2v_ R[64];
#pragma unroll
            for (int i = 0; i < 64; ++i) { const float bt = btv[i]; R[i] = (f32x2v_){bt * bf2f(Vb[i * 128 + c]), bt * egv[i] * bf2f(Kb[i * GQS + c])};
                asm volatile("" : "+v"(R[i]));
                if ((i & 7) == 7) __builtin_amdgcn_sched_barrier(0); }
#pragma unroll
            for (int g8 = 0; g8 < 8; ++g8) { float kd[8];
#pragma unroll
                for (int e = 0; e < 8; ++e) kd[e] = bf2f(Kb[(8 * g8 + e) * GQS + c]) * edv[8 * g8 + e];
                *(GAS v4u*)(KDT + chp * 8192 + c * 64 + 8 * g8) = pack8(kd);
                __builtin_amdgcn_sched_barrier(0); }
            P2A_LBAR();
            f32x4 la[8], lb[8];
            subst_load<0, 0>(la, LTv);
            subst_all(R, la, lb, LTv, std::make_integer_sequence<int, 63>{});
            P2A_LBAR();
            P2A_WS(w3); bf16* UT = (bf16*)(w3 + WS_GUT);
#pragma unroll
            for (int g8 = 0; g8 < 8; ++g8) { v4u o; o.x = pk2(R[8 * g8].x, R[8 * g8 + 1].x); o.y = pk2(R[8 * g8 + 2].x, R[8 * g8 + 3].x); o.z = pk2(R[8 * g8 + 4].x, R[8 * g8 + 5].x); o.w = pk2(R[8 * g8 + 6].x, R[8 * g8 + 7].x);
                *(GAS v4u*)(UT + chp * 8192 + c * 64 + 8 * g8) = o; }
#pragma unroll
            for (int i = 0; i < 64; ++i) Wl[i * 128 + c] = (bf16)f2bf(-R[i].y);
        } else {
            const int tp = t3_ - 256;
            if (has_next) { P2A_WS(w1); p2a_tables(F, pr + F.G, tb_nxt, tp, (const float*)(w1 + WS_BA), (float*)(w1 + WS_GGL)); }
            P2A_LBAR();
            if (has_next) {
#pragma unroll 1
                for (int pass = 0; pass < 2; ++pass) { P2A_WS(w2); int tq_ = tp; asm volatile("" : "+v"(tq_));
                    p2a_prep_block(F, pr + F.G, tb_nxt, (tq_ >> 4) + 16 * pass, tq_ & 15, (const bf16*)(w2 + WS_C), (bf16*)(w2 + WS_GQG)); }
            }
            P2A_LBAR();
        }
        P2A_LBAR();
        { P2A_WS(w4); bf16* WM = (bf16*)(w4 + WS_GWM); int tl_ = tid0; asm volatile("" : "+v"(tl_));
#pragma unroll
          for (int k = 0; k < 4; ++k) { const int idx = tl_ + 512 * k, p = idx >> 10, id = idx & 1023;
              *(GAS v4u*)(WM + (size_t)(ch0 + p) * 8192 + id * 8) = *(const LAS v4u*)((const LAS bf16*)(F.lds + p * GA_SZ + GA_LM) + id * 8); } }
        P2A_LBAR();
        if (has_next) { P2A_WS(w5); int tl_ = tid0; asm volatile("" : "+v"(tl_)); p2a_tiles(F, pr + F.G, tb_nxt, wave, tl_ & 15, (tl_ & 63) >> 4, (bf16*)(w5 + WS_GAM)); }
        P2A_LBAR();
    }
}
#undef P2A_WS
#undef P2A_LBAR

__device__ __forceinline__ void p2b_gdn_scan(const Ctx& F) {
    PHASE_TID();
    constexpr int STS = 136, VNS = 72;
    constexpr int OP0 = 32 * STS * 2 + 32 * VNS * 2;
    constexpr int O_WM = 0, O_QG = 64 * 272, O_AM = 2 * 64 * 272, O_KD = O_AM + 64 * 144, OPB = O_KD + 128 * 144;
    static_assert(OP0 + 2 * OPB <= LDSCTL_OFF, "scan LDS map");
    LAS bf16* ST = (LAS bf16*)F.lds; LAS bf16* VN = (LAS bf16*)(F.lds + 32 * STS * 2);
    const bf16* WM = (const bf16*)(F.ws + WS_GWM); const bf16* UT = (const bf16*)(F.ws + WS_GUT); const bf16* QG = (const bf16*)(F.ws + WS_GQG); const bf16* KDT = (const bf16*)(F.ws + WS_GKD);
    const bf16* AM = (const bf16*)(F.ws + WS_GAM); const float* GL = (const float*)(F.ws + WS_GGL); bf16* OR = (bf16*)(F.ws + WS_OR);
    const int q4 = lane >> 4, r16 = lane & 15, it_ = wave >> 1, dt = wave & 1;
    struct Stage { v4u g[7]; v2u ut; float gl; };
    unsigned lw[7];
#pragma unroll
    for (int k = 0; k < 2; ++k) { const int i = tid + 512 * k; lw[k] = O_WM + (i >> 4) * 272 + (i & 15) * 16; lw[2 + k] = O_QG + (i >> 4) * 272 + (i & 15) * 16; lw[5 + k] = O_KD + (i >> 3) * 144 + (i & 7) * 16; }
    lw[4] = O_AM + (tid >> 3) * 144 + (tid & 7) * 16;
    for (int item = F.vcu; item < BATCH * DNH * 4; item += F.G) {
        const int b = item >> 4, h = (item >> 2) & 3, dvq = item & 3;
        const int ch0 = (b * 4 + h) * 32;
        for (int idx = tid; idx < 32 * STS / 2; idx += NWAVES * 64) ((LAS unsigned*)ST)[idx] = 0u;
        f32x4 Sacc[2]; Sacc[0] = (f32x4){0.f, 0.f, 0.f, 0.f}; Sacc[1] = Sacc[0];
#define GDN_ISSUE(S, chx) do { const size_t cb = (size_t)(chx); \
            _Pragma("unroll") for (int k = 0; k < 2; ++k) { (S).g[k] = *(const GAS v4u*)(WM + cb * 8192 + (size_t)(tid + 512 * k) * 8); (S).g[2 + k] = *(const GAS v4u*)(QG + cb * 8192 + (size_t)(tid + 512 * k) * 8); \
                (S).g[5 + k] = *(const GAS v4u*)(KDT + cb * 8192 + (size_t)(tid + 512 * k) * 8); } \
            (S).g[4] = *(const GAS v4u*)(AM + cb * 4096 + (size_t)tid * 8); \
            (S).ut = *(const GAS v2u*)(UT + cb * 8192 + (dvq * 32 + 16 * dt + r16) * 64 + 16 * it_ + 4 * q4); (S).gl = GL[cb]; } while (0)
#define GDN_WRITE(S, buf) do { _Pragma("unroll") for (int k = 0; k < 7; ++k) *(LAS v4u*)(F.lds + OP0 + (buf) * OPB + lw[k]) = (S).g[k]; } while (0)
#define GDN_LBAR() do { asm volatile("s_waitcnt lgkmcnt(0)" ::: "memory"); __builtin_amdgcn_s_barrier(); asm volatile("" ::: "memory"); } while (0)
        Stage S0, S1, S2;
        GDN_ISSUE(S0, ch0); GDN_ISSUE(S1, ch0 + 1); GDN_ISSUE(S2, ch0 + 2); GDN_WRITE(S0, 0);
        GDN_LBAR();
#define GDN_STEP(SC, SW, cc) do { const int c = (cc); const int bufc = c & 1; \
            const v2u utc = (SC).ut; const float glc = (SC).gl; \
            { const int cl = (c + 3 < SEQ / CHUNK) ? c + 3 : SEQ / CHUNK - 1; GDN_ISSUE(SC, ch0 + cl); } \
            const LAS unsigned char* ob = F.lds + OP0 + bufc * OPB; \
            bf16x8v sf[4], wf[4], qf[4]; \
            _Pragma("unroll") for (int s = 0; s < 4; ++s) { sf[s] = *(const LAS bf16x8v*)(ST + (16 * dt + r16) * STS + 32 * s + 8 * q4); \
                wf[s] = *(const LAS bf16x8v*)(ob + O_WM + (16 * it_ + r16) * 272 + (32 * s + 8 * q4) * 2); qf[s] = *(const LAS bf16x8v*)(ob + O_QG + (16 * it_ + r16) * 272 + (32 * s + 8 * q4) * 2); } \
            f32x4 vacc = (f32x4){bflo(utc.x), bfhi(utc.x), bflo(utc.y), bfhi(utc.y)}; \
            f32x4 oacc = (f32x4){0.f, 0.f, 0.f, 0.f}; \
            _Pragma("unroll") for (int s = 0; s < 4; ++s) { vacc = mfma16(wf[s], sf[s], vacc); oacc = mfma16(sf[s], qf[s], oacc); } \
            { v2u w; w.x = pk2(vacc[0], vacc[1]); w.y = pk2(vacc[2], vacc[3]); *(LAS v2u*)(VN + (16 * dt + r16) * VNS + 16 * it_ + 4 * q4) = w; } \
            GDN_LBAR(); \
            bf16x8v vf[2][2], af[2], kf[2]; \
            _Pragma("unroll") for (int s = 0; s < 2; ++s) { af[s] = *(const LAS bf16x8v*)(ob + O_AM + (16 * it_ + r16) * 144 + (32 * s + 8 * q4) * 2); kf[s] = *(const LAS bf16x8v*)(ob + O_KD + (16 * wave + r16) * 144 + (32 * s + 8 * q4) * 2); } \
            _Pragma("unroll") for (int t = 0; t < 2; ++t) _Pragma("unroll") for (int s = 0; s < 2; ++s) vf[t][s] = *(const LAS bf16x8v*)(VN + (16 * t + r16) * VNS + 32 * s + 8 * q4); \
            _Pragma("unroll") for (int s = 0; s < 2; ++s) { const bf16x8v vo = *(const LAS bf16x8v*)(VN + (16 * dt + r16) * VNS + 32 * s + 8 * q4); oacc = mfma16(vo, af[s], oacc); } \
            { v2u w; w.x = pk2(oacc[0], oacc[1]); w.y = pk2(oacc[2], oacc[3]); *(GAS v2u*)(OR + ((size_t)b * SEQ + c * CHUNK + 16 * it_ + r16) * DNW + h * 128 + dvq * 32 + 16 * dt + 4 * q4) = w; } \
            _Pragma("unroll") for (int t = 0; t < 2; ++t) { Sacc[t] = Sacc[t] * glc; \
                _Pragma("unroll") for (int s = 0; s < 2; ++s) Sacc[t] = mfma16(kf[s], vf[t][s], Sacc[t]); \
                v2u w; w.x = pk2(Sacc[t][0], Sacc[t][1]); w.y = pk2(Sacc[t][2], Sacc[t][3]); *(LAS v2u*)(ST + (16 * t + r16) * STS + 16 * wave + 4 * q4) = w; } \
            GDN_WRITE(SW, bufc ^ 1); \
            GDN_LBAR(); \
        } while (0)
#pragma unroll 1
        for (int c3 = 0; c3 < SEQ / CHUNK; c3 += 3) { GDN_STEP(S0, S1, c3); if (c3 + 1 < SEQ / CHUNK) GDN_STEP(S1, S2, c3 + 1); if (c3 + 2 < SEQ / CHUNK) GDN_STEP(S2, S0, c3 + 2); }
#undef GDN_STEP
#undef GDN_LBAR
#undef GDN_WRITE
#undef GDN_ISSUE
    }
}

__device__ __forceinline__ void p3_mixer_finish(const Ctx& F) {
    PHASE_TID();
    const int gw = F.vcu * NWAVES + wave, NGW = F.G * NWAVES;
    const bf16* PROJ = (const bf16*)(F.ws + WS_C); const bf16* OR = (const bf16*)(F.ws + WS_OR); bf16* Y = (bf16*)(F.ws + WS_Y);
    const int c0 = lane * 8, grp = lane >> 4, win = 2 << grp;
    float gn[8];
    { const f32x4* p = (const f32x4*)(F.g_dn + (c0 & 127)); const f32x4 a = p[0], b = p[1];
#pragma unroll
      for (int e = 0; e < 4; ++e) { gn[e] = a[e]; gn[4 + e] = b[e]; } }
    for (int blk = gw; blk < M / 4; blk += NGW) {
        const int m0 = blk * 4, tok0 = m0 & (SEQ - 1);
        v4u wl[19], zw[4], ow[4];
#pragma unroll
        for (int r = 0; r < 19; ++r) { const int back = 15 - r; const size_t rr = (tok0 - back >= 0) ? (size_t)(m0 - back) : (size_t)m0; wl[r] = *(const GAS v4u*)(PROJ + rr * NPROJ + c0); }
#pragma unroll
        for (int e = 0; e < 4; ++e) { zw[e] = __builtin_nontemporal_load((const GAS v4u*)(PROJ + (size_t)(m0 + e) * NPROJ + 2048 + c0)); ow[e] = __builtin_nontemporal_load((const GAS v4u*)(OR + (size_t)(m0 + e) * DNW + c0)); }
        float S[8];
#pragma unroll
        for (int c = 0; c < 8; ++c) S[c] = 0.f;
        { const int cnt0 = (tok0 + 1) < win ? (tok0 + 1) : win;
#pragma unroll
          for (int i = 0; i < 16; ++i) { float f[8]; unpack8(wl[15 - i], f); const bool on = i < cnt0;
#pragma unroll
              for (int c = 0; c < 8; ++c) S[c] += on ? f[c] : 0.f; } }
#pragma unroll
        for (int e = 0; e < 4; ++e) {
            float u0[8]; unpack8(wl[15 + e], u0);
            if (e > 0) {
                const v4u sel = win == 2 ? wl[13 + e] : (win == 4 ? wl[11 + e] : (win == 8 ? wl[7 + e] : wl[e > 0 ? e - 1 : 0]));
                float fs[8]; unpack8(sel, fs); const bool sub = tok0 + e - win >= 0;
#pragma unroll
                for (int c = 0; c < 8; ++c) S[c] += u0[c] - (sub ? fs[c] : 0.f);
            }
            const int tk = tok0 + e; const int cnt = (tk + 1) < win ? (tk + 1) : win; const float ic = 1.0f / (float)cnt;
            v4u o; o.x = pk2(S[0] * ic - u0[0], S[1] * ic - u0[1]); o.y = pk2(S[2] * ic - u0[2], S[3] * ic - u0[3]); o.z = pk2(S[4] * ic - u0[4], S[5] * ic - u0[5]); o.w = pk2(S[6] * ic - u0[6], S[7] * ic - u0[7]);
            *(GAS v4u*)(Y + (size_t)(m0 + e) * D + c0) = o;
            float ov[8]; unpack8(ow[e], ov);
            float ss = 0.f;
#pragma unroll
            for (int c = 0; c < 8; ++c) ss += ov[c] * ov[c];
            ss = row16_sum(ss);
            const float rs = 1.0f / sqrtf(ss * (1.0f / 128.0f) + 1e-6f);
            float z[8]; unpack8(zw[e], z);
            float y[8];
#pragma unroll
            for (int c = 0; c < 8; ++c) y[c] = ov[c] * rs * gn[c] * silu_f(z[c]);
            v4u o2; o2.x = pk2(y[0], y[1]); o2.y = pk2(y[2], y[3]); o2.z = pk2(y[4], y[5]); o2.w = pk2(y[6], y[7]);
            *(GAS v4u*)(Y + (size_t)(m0 + e) * D + 512 + c0) = o2;
        }
    }
}

__device__ __forceinline__ void p10_final_norm(const Ctx& F) {
    PHASE_TID();
    const int gw = F.vcu * NWAVES + wave, NGW = F.G * NWAVES;
    f32x4 gv[4];
#pragma unroll
    for (int j = 0; j < 4; ++j) gv[j] = ((const f32x4*)F.g_fin)[lane + 64 * j];
    for (int m = gw; m < M; m += NGW) {
        GAS f32x4* xr = (GAS f32x4*)(F.out + (size_t)m * D) + lane;
        f32x4 v[4]; float s = 0.f;
#pragma unroll
        for (int j = 0; j < 4; ++j) { v[j] = xr[64 * j]; s += (v[j][0] * v[j][0] + v[j][1] * v[j][1]) + (v[j][2] * v[j][2] + v[j][3] * v[j][3]); }
        const float rs = 1.0f / sqrtf(wave_sum(s) * (1.0f / D) + pg8::RMS_EPS);
#pragma unroll
        for (int j = 0; j < 4; ++j) xr[64 * j] = v[j] * rs * gv[j];
    }
}

struct Args { const float* in[21]; float* out; unsigned char* ws; int ph_lo, ph_hi, li, pad; };
__global__ void __launch_bounds__(NWAVES * 64, 2) hymba_fwd(Args args) {
    extern __shared__ __attribute__((aligned(16))) unsigned char lds[];
    Ctx F;
    F.lds = (LAS unsigned char*)lds;
    volatile LAS unsigned* MISC = (volatile LAS unsigned*)(F.lds + MISC_OFF);
    F.G = gridDim.x; { const int bx = blockIdx.x; F.vcu = (F.G % 8 == 0) ? (bx % 8) * (F.G / 8) + bx / 8 : bx; }
    F.x = args.in[0]; F.mem = args.in[1]; F.g_mix = args.in[2]; F.w_in = args.in[3]; F.w_pool = args.in[4]; F.pool_scale = args.in[5]; F.conv_w = args.in[6]; F.a_log = args.in[7];
    F.dt_bias = args.in[8]; F.g_dn = args.in[9]; F.w_out = args.in[10]; F.g_xa = args.in[11]; F.g_mem = args.in[12]; F.w_xq = args.in[13]; F.w_xk = args.in[14]; F.w_xv = args.in[15];
    F.w_xo = args.in[16]; F.g_mlp = args.in[17]; F.w_up = args.in[18]; F.w_down = args.in[19]; F.g_fin = args.in[20];
    F.out = args.out; F.ws = args.ws;
    unsigned char* ws = args.ws;
    gu32* ctl = (gu32*)(ws + WS_CTL);
    for (int u = threadIdx.x; u < (LDS_BYTES - LDSCTL_OFF) / 4; u += NWAVES * 64) ((LAS unsigned*)(F.lds + LDSCTL_OFF))[u] = 0u;
    __syncthreads();
    XcdBarrier bar; bar.bar = (unsigned*)(ctl + CW_BAR); bar.x = 0; bar.st = nullptr;
    if (N_LAUNCHES == 1) bar = xcd_barrier_post((unsigned*)(ctl + CW_BAR), MISC + 8);
#define GRID_BAR() do { if (N_LAUNCHES == 1) { xcd_barrier(bar); if (PROBE_REP == 100) xcd_barrier(bar); } } while (0)
    const int lo = args.ph_lo, hi = args.ph_hi;
#define IN(k) (lo <= (k) && (k) < hi)
#define NREP(k) ((PROBE_REP == (k)) ? 2 : 1)
#define BOTH(k) (IN(k) && IN((k) + 1))
    using namespace pg8;
    bf16_t* WIN = (bf16_t*)(ws + WS_WIN); bf16_t* WOUT = (bf16_t*)(ws + WS_WOUT); bf16_t* WQ = (bf16_t*)(ws + WS_WQ); bf16_t* WK = (bf16_t*)(ws + WS_WK);
    bf16_t* WV = (bf16_t*)(ws + WS_WV); bf16_t* WO = (bf16_t*)(ws + WS_WO); bf16_t* WUP = (bf16_t*)(ws + WS_WUP); bf16_t* WDN = (bf16_t*)(ws + WS_WDN);
    bf16_t* MN = (bf16_t*)(ws + WS_MN); bf16_t* KM = (bf16_t*)(ws + WS_KM); bf16_t* VT = (bf16_t*)(ws + WS_VT);
    bf16_t* RA = (bf16_t*)(ws + WS_A); bf16_t* RB = (bf16_t*)(ws + WS_B); bf16_t* RC = (bf16_t*)(ws + WS_C); bf16_t* PS = (bf16_t*)(ws + WS_PS);
    float* SSQ1 = (float*)(ws + WS_SSQ1); float* SSQ2 = (float*)(ws + WS_SSQ2); float* SSQ3 = (float*)(ws + WS_SSQ3);
    const int bx = (int)blockIdx.x;

    if (IN(0)) { for (int rep = 0; rep < NREP(0); ++rep) { p0_prologue(F); __syncthreads(); } if (BOTH(0)) GRID_BAR(); }
    if (IN(1)) {
        for (int rep = 0; rep < NREP(1); ++rep) {
        { Gemm g{RA, WIN, 1024, 1024, 1024}; StaticOrder S; S.init(M, NPROJ, F.G, bx); EpiStore<0, true> E{RC, NPROJ, (const float*)(ws + WS_SSQ0)};
          gemm_phase<EpiStore<0, true>, StaticOrder, true, true>(F.lds, g, S, E); }
        { Gemm g{MN, WK, 1024, 1024, 1024}; StaticOrder S; S.init(MROWS, 1024, F.G, bx); EpiStore<0, false> E{KM, 1024, nullptr};
          gemm_phase<EpiStore<0, false>, StaticOrder, true, true>(F.lds, g, S, E); }
        { Gemm g{WV, MN, 1024, 1024, 1024}; StaticOrder S; S.init(1024, MROWS, F.G, (bx + F.G / 2) % F.G); EpiStore<0, false> E{VT, MROWS, nullptr};
          gemm_phase<EpiStore<0, false>, StaticOrder, true, true>(F.lds, g, S, E); }
        }
        { const int q = F.G / 4; const int seg = bx / q; if ((seg & 1) && F.G % 4 == 0) late_weight_copies(F, (seg >> 1) * q + (bx - seg * q), 2 * q); else if (F.G % 4 != 0 && bx == 0) {   } }
        if (F.G % 4 != 0) late_weight_copies(F, bx, F.G);
        if (BOTH(1)) GRID_BAR();
    }
    if (IN(2)) { for (int rep = 0; rep < NREP(2); ++rep) { p2a_gdn_chunks(F); __syncthreads(); } if (BOTH(2)) GRID_BAR(); }
    if (IN(3)) { for (int rep = 0; rep < NREP(3); ++rep) { p2b_gdn_scan(F); __syncthreads(); } if (BOTH(3)) GRID_BAR(); }
    if (IN(4)) { for (int rep = 0; rep < NREP(4); ++rep) { p3_mixer_finish(F); __syncthreads(); } if (BOTH(4)) GRID_BAR(); }
    if (IN(5)) {
        Gemm g{(const bf16_t*)(ws + WS_Y), WOUT, 1024, 1024, 1024}; StaticOrder S; S.init(M, D, F.G, bx); EpiResid<0> E{(const float*)RA, RB, SSQ1, nullptr, nullptr, nullptr};
        gemm_phase<EpiResid<0>, StaticOrder, true, true>(F.lds, g, S, E);
        if (BOTH(5)) GRID_BAR();
    }
    if (IN(7)) {
        for (int rep = 0; rep < NREP(7); ++rep)
        for (int u0 = F.vcu; u0 < (M / 256) * 4; u0 += 2 * F.G) {
            const int u1 = u0 + F.G, nu = (u1 < (M / 256) * 4) ? 2 : 1;
            const int rt0 = u0 >> 2, h0 = u0 & 3, b0 = rt0 >> 3, rt1 = (nu > 1 ? u1 : u0) >> 2, h1 = (nu > 1 ? u1 : u0) & 3, b1 = rt1 >> 3;
            { Gemm g{RB, WQ, 1024, 1024, 1024}; PairUnits S{Unit{rt0, h0, 0, 0, 0}, Unit{rt1, h1, 0, 0, 0}, nu}; EpiStore<0, true> E{RC, 1024, SSQ1};
              gemm_phase<EpiStore<0, true>, PairUnits, true, true>(F.lds, g, S, E); }
            VM_WAIT(); __syncthreads();
            { Gemm g{RC, KM, 1024, 1024, 256}; PairUnits S{Unit{rt0, b0, (long)h0 * 512, (long)h0 * 512, u0}, Unit{rt1, b1, (long)h1 * 512, (long)h1 * 512, nu > 1 ? u1 : u0}, nu};
              EpiSoftmaxS E{PS, 0.0625f * 1.4426950408889634f, F.lds + RING_BYTES};
              gemm_phase<EpiSoftmaxS, PairUnits, true, true>(F.lds, g, S, E); }
            VM_WAIT(); __syncthreads();
            { Gemm g{PS, VT, 256, MROWS, 256};
              PairUnits S{Unit{rt0, h0, (long)u0 * 131072 - (long)rt0 * 131072, (long)b0 * 512, 0}, Unit{rt1, h1, (long)(nu > 1 ? u1 : u0) * 131072 - (long)rt1 * 131072, (long)b1 * 512, 0}, nu};
              EpiStore<0, false> E{RA, 1024, nullptr};
              gemm_phase<EpiStore<0, false>, PairUnits, true, true>(F.lds, g, S, E); }
            __syncthreads();
        }
        if (BOTH(7)) GRID_BAR();
    }
    if (IN(8)) {
        Gemm g{RA, WO, 1024, 1024, 1024}; StaticOrder S; S.init(M, D, F.G, bx); EpiResid<1> E{nullptr, RB, SSQ2, nullptr, nullptr, nullptr};
        gemm_phase<EpiResid<1>, StaticOrder, true, true>(F.lds, g, S, E);
        if (BOTH(8)) GRID_BAR();
    }
    if (IN(9)) {
        Gemm g{RB, WUP, 1024, 1024, 1024}; StaticOrder S; S.init(M, FF, F.G, bx); EpiStore<1, true> E{RC, FF, SSQ2};
        for (int rep = 0; rep < NREP(9); ++rep) gemm_phase<EpiStore<1, true>, StaticOrder, true, true>(F.lds, g, S, E);
        if (BOTH(9)) GRID_BAR();
    }
    if (IN(10)) {
        Gemm g{RC, WDN, 64, FF, FF, (size_t)32768, (size_t)(FF / 64) * 32768};     StaticOrder S; S.init(M, D, F.G, bx); EpiResid<2> E{nullptr, RB, SSQ3, F.out, F.g_fin, (unsigned*)(ws + WS_CNT3)};
        gemm_phase<EpiResid<2>, StaticOrder, true, true>(F.lds, g, S, E);
    }
#undef IN
#undef BOTH
}

extern "C" void kernel_launch(void* const* d_in, const int* in_sizes, int n_in, void* d_out, int out_size, void* d_ws, size_t ws_size, hipStream_t stream) {
    static int grid = 0;
    if (grid == 0) {
        if (n_in != 21 || in_sizes[0] != M * D || out_size != M * D || ws_size < WS_END) { fprintf(stderr, "kernel_launch: unexpected shapes (n_in %d, in0 %d, out %d, ws %zu); nothing launched\n", n_in, n_in > 0 ? in_sizes[0] : -1, out_size, ws_size); grid = -1; return; }
        int dev = 0, cus = 0, per_cu = 0;
        if (hipGetDevice(&dev) != hipSuccess || hipDeviceGetAttribute(&cus, hipDeviceAttributeMultiprocessorCount, dev) != hipSuccess) { fprintf(stderr, "kernel_launch: device query failed\n"); grid = -1; return; }
        if (hipFuncSetAttribute((const void*)hymba_fwd, hipFuncAttributeMaxDynamicSharedMemorySize, LDS_BYTES) != hipSuccess) { fprintf(stderr, "kernel_launch: hipFuncSetAttribute failed\n"); grid = -1; return; }
        if (hipOccupancyMaxActiveBlocksPerMultiprocessor(&per_cu, (const void*)hymba_fwd, NWAVES * 64, LDS_BYTES) != hipSuccess || per_cu < 1) { fprintf(stderr, "kernel_launch: occupancy query reports %d blocks per CU\n", per_cu); per_cu = 1; }
        (void)hipGetLastError();
        grid = cus;
    }
    if (grid < 0) return;
    if (hipMemsetAsync((char*)d_ws + WS_CTL, 0, CTL_ZERO_BYTES, stream) != hipSuccess) { fprintf(stderr, "kernel_launch: memset failed\n"); return; }
    Args a{};
    for (int i = 0; i < 21; ++i) a.in[i] = (const float*)d_in[i];
    a.out = (float*)d_out; a.ws = (unsigned char*)d_ws;
    for (int li = 0; li < N_LAUNCHES; ++li) {
        a.ph_lo = (N_LAUNCHES == 1) ? 0 : li; a.ph_hi = (N_LAUNCHES == 1) ? N_PHASES : li + 1; a.li = li;
        hipLaunchKernelGGL(hymba_fwd, dim3(grid), dim3(NWAVES * 64), LDS_BYTES, stream, a);
        const hipError_t le = hipPeekAtLastError();
        if (le != hipSuccess) { fprintf(stderr, "kernel_launch: launch %d failed: %s\n", li, hipGetErrorName(le)); break; }
    }
}
```

```cpp
#include <hip/hip_runtime.h>
#include <cstdio>
#include <cstdint>
#include <utility>

#ifndef PROBE_REP
#define PROBE_REP -1
#endif
#ifndef MK_N_LAUNCHES
#define MK_N_LAUNCHES 1
#endif

namespace pg8 {
#define PG8_LAS __attribute__((address_space(3)))
typedef unsigned short bf16_t;
typedef short bf16x8 __attribute__((ext_vector_type(8)));
typedef float f32x4 __attribute__((ext_vector_type(4)));
typedef unsigned u32x4 __attribute__((ext_vector_type(4)));
typedef unsigned u32x2 __attribute__((ext_vector_type(2)));
constexpr int BM = 256, BK = 64, HALF = 128, HTB = HALF * BK * 2  , STAGE_BYTES = 8 * HTB, NXCD = 8, WGM = 4;

__host__ __device__ __forceinline__ int lds_byte(int r, int c) { const int st = (r >> 4) * 2 + (c >> 5), rr = r & 15, cc = c & 31, ob = rr * 64 + cc * 2; return st * 1024 + (ob ^ (((ob >> 9) & 1) << 5)); }
__host__ __device__ __forceinline__ void stage_rc(int b, int& R, int& C) { const int st = b / 1024, sb = b % 1024, swz = sb ^ (((sb >> 9) & 1) << 5); R = (st >> 1) * 16 + swz / 64; C = (st & 1) * 32 + (swz % 64) / 2; }
__host__ __device__ __forceinline__ int perm32(int rho) { const int n = rho >> 4, i = rho & 15; return 8 * (i >> 2) + 4 * n + (i & 3); }
__host__ __device__ __forceinline__ int perm2(int h, int rho) { return 64 * (rho >> 5) + 32 * h + 8 * ((rho >> 2) & 3) + 4 * ((rho >> 4) & 1) + (rho & 3); }

struct Unit { int pm, pn; long ao, bo; int id; };
struct Gemm { const bf16_t* A; const bf16_t* Bt; int lda, ldb, K; size_t akstep = 0, atstep = 0; };

struct StaticOrder {
    int nM, nN, nwg, G, c, rev;
    __host__ __device__ void init(int M, int N, int G_, int c_, int rev_ = 0) { nM = M / BM; nN = N / BM; nwg = nM * nN; G = G_; c = c_; rev = (rev_ && nwg % G == 0) ? 1 : 0; }
    __host__ __device__ bool next(int i, Unit& u) const {
        int ii = i; if (rev) { const int nr = nwg / G; if (i >= nr) return false; ii = nr - 1 - i; }
        const long L = (long)ii * G + c; if (L >= nwg) return false;
        int wgid = (int)L; { const int q = nwg / NXCD, r = nwg % NXCD, xcd = wgid % NXCD, off = wgid / NXCD; wgid = (xcd < r ? xcd * (q + 1) : r * (q + 1) + (xcd - r) * q) + off; }
        const int nig = WGM * nN, gid = wgid / nig, fm = gid * WGM, gsz = (nM - fm) < WGM ? (nM - fm) : WGM;
        u.pm = fm + ((wgid % nig) % gsz); u.pn = (wgid % nig) / gsz; u.ao = 0; u.bo = 0; u.id = 0; return true;
    }
    __device__ __forceinline__ void a_ready(const Unit&) const {}
    __device__ __forceinline__ void done(const Unit&) const {}
};
struct BatchOrder : StaticOrder {
    long bstep;
    __host__ __device__ bool next(int i, Unit& u) const { if (!StaticOrder::next(i, u)) return false; u.bo = (long)(u.pm >> 3) * bstep; return true; }
};
struct OneUnit {
    int pm, pn;
    __device__ __forceinline__ bool next(int i, Unit& u) const { if (i != 0) return false; u.pm = pm; u.pn = pn; u.ao = 0; u.bo = 0; u.id = 0; return true; }
    __device__ __forceinline__ void a_ready(const Unit&) const {}
    __device__ __forceinline__ void done(const Unit&) const {}
};

struct PairUnits {
    Unit u0, u1; int n;
    __device__ __forceinline__ bool next(int i, Unit& u) const { if (i >= n) return false; u = i ? u1 : u0; return true; }
    __device__ __forceinline__ void a_ready(const Unit&) const {}
    __device__ __forceinline__ void done(const Unit&) const {}
};

__device__ __forceinline__ unsigned cvt_pk_bf16(float lo, float hi) { unsigned r; asm volatile("v_cvt_pk_bf16_f32 %0, %1, %2" : "=v"(r) : "v"(lo), "v"(hi)); return r; }

constexpr float RMS_EPS = 1e-6f;
__device__ __forceinline__ float rs_from_ssq(const float* ssq, int row) { return 1.0f / sqrtf(ssq[row] * (1.0f / 1024.0f) + RMS_EPS); }

template <int ACT, bool RS> struct EpiStore {
    static constexpr bool PERM = true, AFTER_DRAIN = false;
    bf16_t* O; int ldc; const float* ssq;
    __device__ __forceinline__ void operator()(const f32x4 (&acc)[2][2][4][2], const Unit& u, int wr, int wc, int fr, int fq) const {
        const int row0 = u.pm * BM + wr * 64 + fr, col0 = u.pn * BM + wc * 64 + 8 * fq;
        float rsv[2][4];
#pragma unroll
        for (int ai = 0; ai < 2; ++ai)
#pragma unroll
            for (int m = 0; m < 4; ++m) rsv[ai][m] = RS ? ssq[row0 + ai * HALF + m * 16] : 0.f;
#pragma unroll
        for (int ai = 0; ai < 2; ++ai)
#pragma unroll
            for (int m = 0; m < 4; ++m) { const int row = row0 + ai * HALF + m * 16;
                bf16_t* rowp = (ACT == 1) ? O + ((size_t)(row >> 8) * (ldc >> 6) + (col0 >> 6)) * 16384 + (size_t)(row & 255) * 64 + (col0 & 63) : O + (size_t)row * ldc + col0;
                float rs = 1.f; if (RS) rs = __builtin_amdgcn_rsqf(rsv[ai][m] * (1.0f / 1024.0f) + RMS_EPS);
#pragma unroll
                for (int bj = 0; bj < 2; ++bj) { f32x4 v0 = acc[ai][bj][m][0], v1 = acc[ai][bj][m][1];
                    if (RS) { v0 = v0 * rs; v1 = v1 * rs; }
                    if (ACT == 1) {
#pragma unroll
                        for (int j = 0; j < 4; ++j) { const float a = v0[j] > 0.f ? v0[j] : 0.f, b = v1[j] > 0.f ? v1[j] : 0.f; v0[j] = a * a; v1[j] = b * b; } }
                    u32x4 w; w.x = cvt_pk_bf16(v0[0], v0[1]); w.y = cvt_pk_bf16(v0[2], v0[3]); w.z = cvt_pk_bf16(v1[0], v1[1]); w.w = cvt_pk_bf16(v1[2], v1[3]);
                    *(u32x4*)(rowp + 32 * bj) = w; } }
    }
};
template <int MODE> struct EpiResid {
    static constexpr bool PERM = true, AFTER_DRAIN = false;
    const float* basef; bf16_t* hb; float* ssq; float* out; const float* gfin; unsigned* cnt;
    static __device__ __forceinline__ void unpk(const u32x4 w, f32x4& lo, f32x4& hi) {
        lo = (f32x4){__builtin_bit_cast(float, w.x << 16), __builtin_bit_cast(float, w.x & 0xffff0000u), __builtin_bit_cast(float, w.y << 16), __builtin_bit_cast(float, w.y & 0xffff0000u)};
        hi = (f32x4){__builtin_bit_cast(float, w.z << 16), __builtin_bit_cast(float, w.z & 0xffff0000u), __builtin_bit_cast(float, w.w << 16), __builtin_bit_cast(float, w.w & 0xffff0000u)}; }
    __device__ __forceinline__ void operator()(f32x4 (&acc)[2][2][4][2], const Unit& u, int wr, int wc, int fr, int fq) const {
        const int row0 = u.pm * BM + wr * 64 + fr, col0 = u.pn * BM + wc * 64 + 8 * fq;
#pragma unroll
        for (int ai = 0; ai < 2; ++ai) {
            u32x4 bs[4][2];
#pragma unroll
            for (int m = 0; m < 4; ++m)
#pragma unroll
                for (int bj = 0; bj < 2; ++bj) { const size_t o2 = (size_t)(row0 + ai * HALF + m * 16) * 1024 + col0 + 32 * bj;
                    if (MODE == 0) bs[m][bj] = __builtin_nontemporal_load((const u32x4*)((const bf16_t*)basef + o2));
                    else bs[m][bj] = *(const u32x4*)(hb + o2); }
            float ssm[4];
#pragma unroll
            for (int m = 0; m < 4; ++m) { const int row = row0 + ai * HALF + m * 16; const size_t off = (size_t)row * 1024 + col0; float ss = 0.f;
#pragma unroll
                for (int bj = 0; bj < 2; ++bj) { f32x4 b0, b1; unpk(bs[m][bj], b0, b1);
                    const f32x4 o0 = b0 + acc[ai][bj][m][0], o1 = b1 + acc[ai][bj][m][1];
                    ss += ((o0[0] * o0[0] + o0[1] * o0[1]) + (o0[2] * o0[2] + o0[3] * o0[3])) + ((o1[0] * o1[0] + o1[1] * o1[1]) + (o1[2] * o1[2] + o1[3] * o1[3]));
                    if (MODE == 2) { acc[ai][bj][m][0] = o0; acc[ai][bj][m][1] = o1; }
                    else { u32x4 w; w.x = cvt_pk_bf16(o0[0], o0[1]); w.y = cvt_pk_bf16(o0[2], o0[3]); w.z = cvt_pk_bf16(o1[0], o1[1]); w.w = cvt_pk_bf16(o1[2], o1[3]); *(u32x4*)(hb + off + 32 * bj) = w; } }
                ssm[m] = ss; }
            { float t[4];
#pragma unroll
              for (int m = 0; m < 4; ++m) t[m] = __shfl_xor(ssm[m], 16);
#pragma unroll
              for (int m = 0; m < 4; ++m) ssm[m] += t[m];
#pragma unroll
              for (int m = 0; m < 4; ++m) t[m] = __shfl_xor(ssm[m], 32);
#pragma unroll
              for (int m = 0; m < 4; ++m) ssm[m] += t[m];
              if (fq == 0) {
#pragma unroll
                  for (int m = 0; m < 4; ++m) atomicAdd(ssq + row0 + ai * HALF + m * 16, ssm[m]); } }
            asm volatile("" ::: "memory"); }
        if (MODE == 2) {
            asm volatile("s_waitcnt vmcnt(0)" ::: "memory");
            unsigned* c = cnt + 64 * u.pm;
            if (fr == 0 && fq == 0) __hip_atomic_fetch_add(c, 1u, __ATOMIC_RELAXED, __HIP_MEMORY_SCOPE_AGENT);
            unsigned spins = 0;
            while (__hip_atomic_load(c, __ATOMIC_RELAXED, __HIP_MEMORY_SCOPE_AGENT) < 32u) { __builtin_amdgcn_s_sleep(2); if (++spins > (1u << 22)) break; }
            asm volatile("" ::: "memory");
            f32x4 gv[2][2];
#pragma unroll
            for (int bj = 0; bj < 2; ++bj)
#pragma unroll
                for (int n = 0; n < 2; ++n) gv[bj][n] = *(const f32x4*)(gfin + col0 + 32 * bj + n * 4);
            float sv[2][4];
#pragma unroll
            for (int ai = 0; ai < 2; ++ai)
#pragma unroll
                for (int m = 0; m < 4; ++m) sv[ai][m] = __hip_atomic_load(ssq + row0 + ai * HALF + m * 16, __ATOMIC_RELAXED, __HIP_MEMORY_SCOPE_AGENT);
#pragma unroll
            for (int ai = 0; ai < 2; ++ai)
#pragma unroll
                for (int m = 0; m < 4; ++m) { const float rs = __builtin_amdgcn_rsqf(sv[ai][m] * (1.0f / 1024.0f) + RMS_EPS); const size_t off = (size_t)(row0 + ai * HALF + m * 16) * 1024 + col0;
#pragma unroll
                    for (int bj = 0; bj < 2; ++bj)
#pragma unroll
                        for (int n = 0; n < 2; ++n) *(f32x4*)(out + off + 32 * bj + n * 4) = acc[ai][bj][m][n] * rs * gv[bj][n]; }
        }
    }
};
struct EpiSoftmaxRow {
    static constexpr bool PERM = true, AFTER_DRAIN = false;
    bf16_t* P; int ldp; const float* ssq; float scale_log2e; PG8_LAS unsigned char* tab;
    __device__ __forceinline__ void operator()(f32x4 (&acc)[2][2][4][2], const Unit& u, int wr, int wc, int fr, int fq) const {
        PG8_LAS float* RM = (PG8_LAS float*)tab;
        PG8_LAS float* RSM = (PG8_LAS float*)(tab + 4096);
        const int row0 = u.pm * BM + wr * 64 + fr;
        float rsv[2][4];
#pragma unroll
        for (int ai = 0; ai < 2; ++ai)
#pragma unroll
            for (int m = 0; m < 4; ++m) rsv[ai][m] = ssq[row0 + ai * HALF + m * 16];
#pragma unroll
        for (int ai = 0; ai < 2; ++ai)
#pragma unroll
            for (int m = 0; m < 4; ++m) { float mx = -3.0e38f;
#pragma unroll
                for (int bj = 0; bj < 2; ++bj)
#pragma unroll
                    for (int n = 0; n < 2; ++n) { const f32x4 x = acc[ai][bj][m][n];
                        asm("v_max3_f32 %0, %0, %1, %2" : "+v"(mx) : "v"(x[0]), "v"(x[1])); asm("v_max3_f32 %0, %0, %1, %2" : "+v"(mx) : "v"(x[2]), "v"(x[3])); }
                { const float t1 = __shfl_xor(mx, 16); asm("v_max_f32 %0, %0, %1" : "+v"(mx) : "v"(t1)); const float t2 = __shfl_xor(mx, 32); asm("v_max_f32 %0, %0, %1" : "+v"(mx) : "v"(t2)); }
                if (fq == 0) RM[(ai * HALF + wr * 64 + m * 16 + fr) * 4 + wc] = mx; }
        asm volatile("s_waitcnt lgkmcnt(0)" ::: "memory"); __builtin_amdgcn_s_barrier(); asm volatile("" ::: "memory");
#pragma unroll
        for (int ai = 0; ai < 2; ++ai)
#pragma unroll
            for (int m = 0; m < 4; ++m) { const int r = ai * HALF + wr * 64 + m * 16 + fr; const f32x4 m4 = *(const PG8_LAS f32x4*)(RM + r * 4);
                float gm = m4[0]; asm("v_max3_f32 %0, %0, %1, %2" : "+v"(gm) : "v"(m4[1]), "v"(m4[2])); asm("v_max_f32 %0, %0, %1" : "+v"(gm) : "v"(m4[3])); float s = 0.f;
                const float sc = scale_log2e * __builtin_amdgcn_rsqf(rsv[ai][m] * (1.0f / 1024.0f) + RMS_EPS);
                const float nb = -gm * sc;
#pragma unroll
                for (int bj = 0; bj < 2; ++bj)
#pragma unroll
                    for (int n = 0; n < 2; ++n) { f32x4 x = acc[ai][bj][m][n];
#pragma unroll
                        for (int j = 0; j < 4; ++j) { x[j] = __builtin_amdgcn_exp2f(__builtin_fmaf(x[j], sc, nb)); s += x[j]; }
                        acc[ai][bj][m][n] = x; }
                s += __shfl_xor(s, 16); s += __shfl_xor(s, 32);
                if (fq == 0) RSM[r * 4 + wc] = s; }
        asm volatile("s_waitcnt lgkmcnt(0)" ::: "memory"); __builtin_amdgcn_s_barrier(); asm volatile("" ::: "memory");
        const int col0 = u.pn * BM + wc * 64 + 8 * fq;
#pragma unroll
        for (int ai = 0; ai < 2; ++ai)
#pragma unroll
            for (int m = 0; m < 4; ++m) { const int r = ai * HALF + wr * 64 + m * 16 + fr; const f32x4 s4 = *(const PG8_LAS f32x4*)(RSM + r * 4);
                const float inv = __builtin_amdgcn_rcpf((s4[0] + s4[1]) + (s4[2] + s4[3])); bf16_t* rowp = P + (size_t)(u.pm * BM + r) * ldp + col0;
#pragma unroll
                for (int bj = 0; bj < 2; ++bj) { const f32x4 v0 = acc[ai][bj][m][0] * inv, v1 = acc[ai][bj][m][1] * inv;
                    u32x4 w; w.x = cvt_pk_bf16(v0[0], v0[1]); w.y = cvt_pk_bf16(v0[2], v0[3]); w.z = cvt_pk_bf16(v1[0], v1[1]); w.w = cvt_pk_bf16(v1[2], v1[3]);
                    *(u32x4*)(rowp + 32 * bj) = w; } }
    }
};

template <class Epi, class Sched, bool ALIGN_EPI = false, bool SP2 = false>
__device__ __forceinline__ void gemm_phase(PG8_LAS unsigned char* lds, const Gemm g, const Sched& S, const Epi& E) {
    int tid_ = threadIdx.x; asm volatile("" : "+v"(tid_));
    const int tid = tid_, wid = __builtin_amdgcn_readfirstlane(tid >> 6), lane = tid & 63, wr = wid >> 2, wc = wid & 3, fr = lane & 15, fq = lane >> 4;
    const int K = g.K, nt = K / BK;
    unsigned voffA[2], voffB0[2], voffB1[2];
#pragma unroll
    for (int i = 0; i < 2; ++i) { int R, C; stage_rc(tid * 16 + i * 8192, R, C);
        voffA[i] = (unsigned)(R * g.lda + C) * 2u;
        voffB0[i] = (unsigned)((Epi::PERM ? perm2(0, R) : R) * g.ldb + C) * 2u; voffB1[i] = (unsigned)((Epi::PERM ? perm2(1, R) : HALF + R) * g.ldb + C) * 2u; }
    const size_t kstep = (size_t)(BK * 2);
    const size_t hstepA = (size_t)HALF * g.lda * 2, hstepB = (size_t)HALF * g.ldb * 2;
    const size_t tstepA = g.atstep ? g.atstep : 2 * hstepA, tstepB = 2 * hstepB;
    const size_t kstepA = g.akstep ? g.akstep : kstep;
    const unsigned ldsw = (unsigned)wid * 1024u;
    const int aoff = lds_byte(wr * 64 + fr, fq * 8), boff = lds_byte(wc * 32 + fr, fq * 8);
#define PG8_SA(b, h) (((b) * 2 + (h)) * HTB)
#define PG8_SB(b, h) ((4 + (b) * 2 + (h)) * HTB)
#define PG8_STAGE(bufoff, gbase, voff) do { _Pragma("unroll") for (int _i = 0; _i < 2; ++_i) \
        __builtin_amdgcn_global_load_lds((const unsigned*)((const char*)(gbase) + (voff)[_i]), (PG8_LAS unsigned*)(lds + (bufoff) + ldsw + _i * 8192), 16, 0, 0); } while (0)
#define PG8_LDA(dst, b, h) do { _Pragma("unroll") for (int m = 0; m < 4; ++m) _Pragma("unroll") for (int k = 0; k < 2; ++k) dst[m][k] = *(const PG8_LAS bf16x8*)(lds + PG8_SA(b, h) + aoff + m * 2048 + k * 1024); } while (0)
#define PG8_LDB(dst, b, h) do { _Pragma("unroll") for (int n = 0; n < 2; ++n) _Pragma("unroll") for (int k = 0; k < 2; ++k) dst[n][k] = *(const PG8_LAS bf16x8*)(lds + PG8_SB(b, h) + boff + n * 2048 + k * 1024); } while (0)
#define PG8_MMA(ai, bj, At, Bt) do { __builtin_amdgcn_s_setprio(1); _Pragma("unroll") for (int m = 0; m < 4; ++m) _Pragma("unroll") for (int n = 0; n < 2; ++n) _Pragma("unroll") for (int k = 0; k < 2; ++k) \
        acc[ai][bj][m][n] = __builtin_amdgcn_mfma_f32_16x16x32_bf16(Bt[n][k], At[m][k], acc[ai][bj][m][n], 0, 0, 0); __builtin_amdgcn_s_setprio(0); } while (0)
#define PG8_WAIT_V(n) asm volatile("s_waitcnt vmcnt(" #n ")" ::: "memory")
#define PG8_WAIT_L(n) asm volatile("s_waitcnt lgkmcnt(" #n ")" ::: "memory")
#define PG8_BAR __builtin_amdgcn_s_barrier()
#define PG8_SCHED __builtin_amdgcn_sched_barrier(0)
    Unit cur, nxt; int ui = 0;
    if (!S.next(0, cur)) return;
    f32x4 acc[2][2][4][2];
#pragma unroll
    for (int a = 0; a < 2; ++a)
#pragma unroll
        for (int b = 0; b < 2; ++b)
#pragma unroll
            for (int m = 0; m < 4; ++m)
#pragma unroll
                for (int n = 0; n < 2; ++n) acc[a][b][m][n] = (f32x4){0.f, 0.f, 0.f, 0.f};
    bf16x8 At[4][2], B0[2][2], B1[2][2];
    const char* cA = (const char*)g.A + (size_t)cur.pm * tstepA + cur.ao; const char* cB = (const char*)g.Bt + (size_t)cur.pn * tstepB + cur.bo;
    S.a_ready(cur);
    if constexpr (SP2) {
        PG8_STAGE(PG8_SB(0, 0), cB, voffB0); PG8_STAGE(PG8_SB(0, 1), cB, voffB1); PG8_STAGE(PG8_SA(0, 0), cA, voffA); PG8_STAGE(PG8_SA(0, 1), cA + hstepA, voffA);
        if (wr == 1) PG8_BAR;
        PG8_WAIT_V(2); PG8_BAR;
        PG8_STAGE(PG8_SB(1, 0), cB + kstep, voffB0); PG8_STAGE(PG8_SA(1, 0), cA + kstepA, voffA); PG8_STAGE(PG8_SB(1, 1), cB + kstep, voffB1);
        PG8_WAIT_V(6); PG8_BAR;
    } else {
        PG8_STAGE(PG8_SB(0, 0), cB, voffB0); PG8_STAGE(PG8_SA(0, 0), cA, voffA); PG8_STAGE(PG8_SB(0, 1), cB, voffB1); PG8_STAGE(PG8_SA(0, 1), cA + hstepA, voffA);
        if (wr == 1) PG8_BAR;
        PG8_WAIT_V(4); PG8_BAR;
        PG8_STAGE(PG8_SB(1, 0), cB + kstep, voffB0); PG8_STAGE(PG8_SA(1, 0), cA + kstepA, voffA); PG8_STAGE(PG8_SB(1, 1), cB + kstep, voffB1);
        PG8_WAIT_V(6); PG8_BAR;
    }
    for (;;) {
        const bool has_next = S.next(ui + 1, nxt);
        const char* nA = has_next ? (const char*)g.A + (size_t)nxt.pm * tstepA + nxt.ao : cA; const char* nB = has_next ? (const char*)g.Bt + (size_t)nxt.pn * tstepB + nxt.bo : cB;
#pragma unroll 1
        for (int t = 0; t < nt; t += 2) {
            const bool last = (t == nt - 2);
            const char* a1 = cA + (size_t)(t + 1) * kstepA;
            const char* a2 = last ? nA : cA + (size_t)(t + 2) * kstepA; const char* b2 = last ? nB : cB + (size_t)(t + 2) * kstep;
            const char* a3 = a2 + kstepA; const char* b3 = b2 + kstep;
            if (last && has_next) S.a_ready(nxt);
            if constexpr (SP2) {
            PG8_LDB(B0, 0, 0); PG8_LDB(B1, 0, 1); PG8_SCHED; PG8_LDA(At, 0, 0); PG8_STAGE(PG8_SA(1, 1), a1 + hstepA, voffA);
            PG8_WAIT_V(8); PG8_WAIT_L(0); PG8_BAR; PG8_MMA(0, 0, At, B0); PG8_MMA(0, 1, At, B1); PG8_BAR; PG8_SCHED;
            PG8_LDA(At, 0, 1); PG8_STAGE(PG8_SB(0, 0), b2, voffB0); PG8_STAGE(PG8_SB(0, 1), b2, voffB1); PG8_STAGE(PG8_SA(0, 0), a2, voffA);
            PG8_WAIT_V(8); PG8_WAIT_L(0); PG8_BAR; PG8_MMA(1, 0, At, B0); PG8_MMA(1, 1, At, B1); PG8_BAR; PG8_SCHED;
            PG8_LDB(B0, 1, 0); PG8_LDB(B1, 1, 1); PG8_SCHED; PG8_LDA(At, 1, 0); PG8_STAGE(PG8_SA(0, 1), a2 + hstepA, voffA);
            PG8_WAIT_V(8); PG8_WAIT_L(0); PG8_BAR; PG8_MMA(0, 0, At, B0); PG8_MMA(0, 1, At, B1); PG8_BAR; PG8_SCHED;
            PG8_LDA(At, 1, 1); PG8_STAGE(PG8_SB(1, 0), b3, voffB0); PG8_STAGE(PG8_SB(1, 1), b3, voffB1); PG8_STAGE(PG8_SA(1, 0), a3, voffA);
            PG8_WAIT_V(8); PG8_WAIT_L(0); PG8_BAR; PG8_MMA(1, 0, At, B0); PG8_MMA(1, 1, At, B1); PG8_BAR; PG8_SCHED;
            } else {
            PG8_LDB(B0, 0, 0); PG8_SCHED; PG8_LDA(At, 0, 0); PG8_STAGE(PG8_SA(1, 1), a1 + hstepA, voffA);
            PG8_WAIT_L(8); PG8_BAR; PG8_WAIT_L(0); PG8_MMA(0, 0, At, B0); PG8_BAR; PG8_SCHED;
            PG8_LDB(B1, 0, 1); PG8_STAGE(PG8_SB(0, 0), b2, voffB0);
            PG8_BAR; PG8_WAIT_L(0); PG8_MMA(0, 1, At, B1); PG8_BAR;
            PG8_LDA(At, 0, 1); PG8_STAGE(PG8_SA(0, 0), a2, voffA);
            PG8_BAR; PG8_WAIT_L(0); PG8_MMA(1, 0, At, B0); PG8_BAR; PG8_SCHED;
            PG8_STAGE(PG8_SB(0, 1), b2, voffB1);
            PG8_WAIT_V(6); PG8_BAR; PG8_MMA(1, 1, At, B1); PG8_BAR;
            PG8_LDB(B0, 1, 0); PG8_SCHED; PG8_LDA(At, 1, 0); PG8_STAGE(PG8_SA(0, 1), a2 + hstepA, voffA);
            PG8_WAIT_L(8); PG8_BAR; PG8_WAIT_L(0); PG8_MMA(0, 0, At, B0); PG8_BAR; PG8_SCHED;
            PG8_LDB(B1, 1, 1); PG8_STAGE(PG8_SB(1, 0), b3, voffB0);
            PG8_BAR; PG8_WAIT_L(0); PG8_MMA(0, 1, At, B1); PG8_BAR;
            PG8_LDA(At, 1, 1); PG8_STAGE(PG8_SA(1, 0), a3, voffA);
            PG8_BAR; PG8_WAIT_L(0); PG8_MMA(1, 0, At, B0); PG8_BAR; PG8_SCHED;
            PG8_STAGE(PG8_SB(1, 1), b3, voffB1);
            PG8_WAIT_V(6); PG8_BAR; PG8_MMA(1, 1, At, B1); PG8_BAR;
            }
        }
        if constexpr (ALIGN_EPI) { if (wr == 0) PG8_BAR; }
        if constexpr (!Epi::AFTER_DRAIN) { E(acc, cur, wr, wc, fr, fq); S.done(cur); }
        if (!has_next) break;
#pragma unroll
        for (int a = 0; a < 2; ++a)
#pragma unroll
            for (int b = 0; b < 2; ++b)
#pragma unroll
                for (int m = 0; m < 4; ++m)
#pragma unroll
                    for (int n = 0; n < 2; ++n) acc[a][b][m][n] = (f32x4){0.f, 0.f, 0.f, 0.f};
        cur = nxt; cA = nA; cB = nB; ++ui;
        if constexpr (ALIGN_EPI) { if (wr == 1) PG8_BAR; }
    }
    PG8_WAIT_V(0);
    if constexpr (!ALIGN_EPI) { if (wr == 0) PG8_BAR; }
    PG8_BAR;
    if constexpr (Epi::AFTER_DRAIN) { E.fused(acc, cur, wr, wc, fr, fq, lds, wid, lane); S.done(cur); }
#undef PG8_SA
#undef PG8_SB
#undef PG8_STAGE
#undef PG8_LDA
#undef PG8_LDB
#undef PG8_MMA
#undef PG8_WAIT_V
#undef PG8_WAIT_L
#undef PG8_BAR
#undef PG8_SCHED
}
}

constexpr int NWAVES = 8;
constexpr int N_LAUNCHES = MK_N_LAUNCHES;
constexpr int N_PHASES = 11;
constexpr int BATCH = 16, SEQ = 2048, D = 1024, M = BATCH * SEQ;
constexpr int NPROJ = 2560, INCOLS = 2568, MEML = 256, MROWS = BATCH * MEML, FF = 4096;
constexpr int DNW = 512, DNH = 4, DNHD = 128, CHUNK = 64;

constexpr size_t MiB = 1u << 20;
constexpr size_t WS_CTL = 0, CTL_ZERO_BYTES = 1 * MiB;
constexpr size_t WS_BA = 1 * MiB;
constexpr size_t WS_SSQ1 = 256 * 1024, WS_SSQ2 = 512 * 1024, WS_SSQ3 = 768 * 1024, WS_CNT3 = 896 * 1024;
constexpr size_t WS_WIN = 8 * MiB, WS_WOUT = 13 * MiB, WS_WQ = 15 * MiB, WS_WK = 17 * MiB, WS_WV = 19 * MiB, WS_WO = 21 * MiB, WS_WUP = 23 * MiB, WS_WDN = 31 * MiB;
constexpr size_t WS_MN = 40 * MiB, WS_KM = 48 * MiB, WS_VT = 56 * MiB;
constexpr size_t WS_A = 64 * MiB;
constexpr size_t WS_SSQ0 = 2 * MiB;
constexpr size_t WS_Y = 352 * MiB;
constexpr size_t WS_B = 128 * MiB;
constexpr size_t WS_C = 192 * MiB;
constexpr size_t WS_PS = 256 * MiB;
constexpr size_t WS_OR = 128 * MiB;
constexpr size_t WS_GWM = 352 * MiB, WS_GUT = 384 * MiB, WS_GQG = 416 * MiB, WS_GKD = 448 * MiB, WS_GAM = 480 * MiB, WS_GGL = 496 * MiB;
constexpr size_t WS_END = 497 * MiB;
constexpr int CW_BAR = 4096;

constexpr int RING_BYTES = 131072;
constexpr int LDS_BYTES = 147456;
constexpr int LDSCTL_OFF = LDS_BYTES - 512, MISC_OFF = LDSCTL_OFF + 320;

#define GAS __attribute__((address_space(1)))
#define LAS __attribute__((address_space(3)))
typedef unsigned short bf16;
typedef unsigned v4u __attribute__((ext_vector_type(4)));
typedef unsigned v2u __attribute__((ext_vector_type(2)));
typedef float f32x4 __attribute__((ext_vector_type(4)));
typedef GAS unsigned gu32;
#define LDS_WAIT() asm volatile("s_waitcnt lgkmcnt(0)" ::: "memory")
#define VM_WAIT() asm volatile("s_waitcnt vmcnt(0)" ::: "memory")
typedef float f32x2_t __attribute__((ext_vector_type(2)));
typedef __bf16 bf16x2_t __attribute__((ext_vector_type(2)));
__device__ __forceinline__ unsigned pk2(float lo, float hi) { const f32x2_t v = {lo, hi}; const bf16x2_t b = __builtin_convertvector(v, bf16x2_t); return __builtin_bit_cast(unsigned, b); }
__device__ __forceinline__ unsigned f2bf(float f) { return pk2(f, 0.f) & 0xffffu; }
__device__ __forceinline__ float bflo(unsigned w) { return __builtin_bit_cast(float, w << 16); }
__device__ __forceinline__ float bfhi(unsigned w) { return __builtin_bit_cast(float, w & 0xffff0000u); }
__device__ __forceinline__ void unpack8(const v4u w, float (&f)[8]) { f[0] = bflo(w.x); f[1] = bfhi(w.x); f[2] = bflo(w.y); f[3] = bfhi(w.y); f[4] = bflo(w.z); f[5] = bfhi(w.z); f[6] = bflo(w.w); f[7] = bfhi(w.w); }

#define XB_TMO      128
#define XB_XCNT(j)  (256  + 64 * (j))
#define XB_XSUB(j)  (1280 + 64 * (j))
#define XB_XGEN(j)  (2304 + 64 * (j))
#define XB_TOP      3328
#define XB_TOPGEN   3392
#define XCD_BAR_WORDS 3456
#define XB_SPIN_CAP (1u << 18)
__device__ __forceinline__ unsigned xb_ld(unsigned* p)              { return __hip_atomic_load(p, __ATOMIC_RELAXED, __HIP_MEMORY_SCOPE_AGENT); }
__device__ __forceinline__ unsigned xb_add(unsigned* p, unsigned v) { return __hip_atomic_fetch_add(p, v, __ATOMIC_RELAXED, __HIP_MEMORY_SCOPE_AGENT); }
__device__ __forceinline__ unsigned xb_xcc_id() { return (unsigned)__builtin_amdgcn_s_getreg((3 << 11) | 20) & 0xFu; }
#define XB_SPIN(cond, bar) do { unsigned _sp = 0; while (cond) { __builtin_amdgcn_s_sleep(1); \
    if ((++_sp & 255u) == 0u) { if (xb_ld(&(bar)[XB_TMO])) break; if (_sp > XB_SPIN_CAP) { atomicAdd(&(bar)[XB_TMO], 1u); break; } } } } while (0)
struct XcdBarrier { unsigned* bar; unsigned x; volatile LAS unsigned* st; };
__device__ __forceinline__ XcdBarrier xcd_barrier_post(unsigned* bar, volatile LAS unsigned* st) {
    XcdBarrier b; b.bar = bar; b.x = xb_xcc_id(); b.st = st;
    if (threadIdx.x == 0) (void)xb_add(&bar[XB_XCNT(b.x)], 1u);
    return b;
}
__device__ __forceinline__ void xcd_barrier_complete(unsigned* bar, unsigned x, unsigned& nloc, unsigned& nx) {
    const unsigned G = gridDim.x * gridDim.y * gridDim.z;
    unsigned sum, cnt, mine, sp = 0u;
    for (;;) {
        sum = 0u; cnt = 0u; mine = 0u;
#pragma unroll
        for (unsigned j = 0; j < 16; ++j) { const unsigned c = xb_ld(&bar[XB_XCNT(j)]); sum += c; cnt += (c > 0u) ? 1u : 0u; mine = (j == x) ? c : mine; }
        if (sum == G) break;
        __builtin_amdgcn_s_sleep(1);
        if ((++sp & 255u) == 0u) { if (xb_ld(&bar[XB_TMO])) break; if (sp > XB_SPIN_CAP) { atomicAdd(&bar[XB_TMO], 1u); break; } }
    }
    nloc = mine > 0u ? mine : 1u; nx = cnt > 0u ? cnt : 1u;
}
__device__ __forceinline__ void xcd_barrier(const XcdBarrier& b) {
    asm volatile("s_waitcnt vmcnt(0)" ::: "memory");
    __syncthreads();
    if (threadIdx.x == 0) {
        unsigned* bar = b.bar;
        __builtin_amdgcn_s_waitcnt(0);
        unsigned nloc = b.st[0], nx = b.st[1];
        if (nloc == 0u) { xcd_barrier_complete(bar, b.x, nloc, nx); b.st[0] = nloc; b.st[1] = nx; }
        const unsigned old = xb_add(&bar[XB_XSUB(b.x)], 1u);
        const unsigned gen = old / nloc;
        if (old + 1u == (gen + 1u) * nloc) {
            __builtin_amdgcn_fence(__ATOMIC_RELEASE, "agent");
            asm volatile("s_waitcnt vmcnt(0)" ::: "memory");
            const unsigned og = xb_add(&bar[XB_TOP], 1u);
            const unsigned tg = og / nx;
            if (og + 1u == (tg + 1u) * nx) xb_add(&bar[XB_TOPGEN], 1u);
            else XB_SPIN(xb_ld(&bar[XB_TOPGEN]) == tg, bar);
            __builtin_amdgcn_fence(__ATOMIC_ACQUIRE, "agent");
            xb_add(&bar[XB_XGEN(b.x)], 1u);
            asm volatile("s_waitcnt vmcnt(0)" ::: "memory");
        } else {
            XB_SPIN(xb_ld(&bar[XB_XGEN(b.x)]) == gen, bar);
            __builtin_amdgcn_fence(__ATOMIC_ACQUIRE, "agent");
            asm volatile("s_waitcnt vmcnt(0)" ::: "memory");
        }
    }
    __syncthreads();
}


__device__ __forceinline__ float dppf(float v, const int ctrl_sel) {
    const int x = __builtin_bit_cast(int, v); int r;
    if (ctrl_sel == 0) r = __builtin_amdgcn_update_dpp(0, x, 0xB1, 0xF, 0xF, true);
    else if (ctrl_sel == 1) r = __builtin_amdgcn_update_dpp(0, x, 0x4E, 0xF, 0xF, true);
    else if (ctrl_sel == 2) r = __builtin_amdgcn_update_dpp(0, x, 0x141, 0xF, 0xF, true);
    else r = __builtin_amdgcn_update_dpp(0, x, 0x140, 0xF, 0xF, true);
    return __builtin_bit_cast(float, r);
}
__device__ __forceinline__ float row16_sum(float v) {
    v += dppf(v, 0); v += dppf(v, 1); v += dppf(v, 2); v += dppf(v, 3); return v;
}
__device__ __forceinline__ float wave_sum(float v) {
    v = row16_sum(v);
    const int x = __builtin_bit_cast(int, v);
    const float a = __builtin_bit_cast(float, __builtin_amdgcn_readlane(x, 0)), b = __builtin_bit_cast(float, __builtin_amdgcn_readlane(x, 16));
    const float c = __builtin_bit_cast(float, __builtin_amdgcn_readlane(x, 32)), d = __builtin_bit_cast(float, __builtin_amdgcn_readlane(x, 48));
    return (a + b) + (c + d);
}
__device__ __forceinline__ float silu_f(float x) { return x * __builtin_amdgcn_rcpf(1.0f + __expf(-x)); }

#define PHASE_TID() int tid_ = threadIdx.x; asm volatile("" : "+v"(tid_)); const int tid = tid_, lane = tid & 63, wave = __builtin_amdgcn_readfirstlane(tid >> 6); (void)lane; (void)wave
struct Ctx {
    LAS unsigned char* lds;
    int vcu, G;
    const float *x, *mem, *g_mix, *w_in, *w_pool, *pool_scale, *conv_w, *a_log, *dt_bias, *g_dn, *w_out, *g_xa, *g_mem, *w_xq, *w_xk, *w_xv, *w_xo, *g_mlp, *w_up, *w_down, *g_fin;
    float* out; unsigned char* ws;
};

__device__ __forceinline__ void transpose_item(const float* W, int ldw, int nblk, const float* kscale, bf16* WT, int ldt, int koff, LAS float* scr, int item, int lane) {
    const int kb = item / nblk, nb = item % nblk, k0 = 64 * kb, n0 = 32 * nb;
    f32x4 wv[8];
#pragma unroll
    for (int i = 0; i < 8; ++i) wv[i] = __builtin_nontemporal_load((const f32x4*)(W + (size_t)(k0 + (lane >> 3) + 8 * i) * ldw + n0 + 4 * (lane & 7)));
#pragma unroll
    for (int i = 0; i < 8; ++i) { const int kk = (lane >> 3) + 8 * i; f32x4 v = wv[i]; if (kscale) v = v * kscale[k0 + kk];
        LAS float* d = scr + kk * 33 + 4 * (lane & 7); d[0] = v[0]; d[1] = v[1]; d[2] = v[2]; d[3] = v[3]; }
    LDS_WAIT(); asm volatile("" ::: "memory");
    const int c = lane & 7;
#pragma unroll
    for (int j = 0; j < 4; ++j) { const int n = (lane >> 3) + 8 * j; const LAS float* s = scr + (8 * c) * 33 + n;
        v4u o; o.x = pk2(s[0 * 33], s[1 * 33]); o.y = pk2(s[2 * 33], s[3 * 33]); o.z = pk2(s[4 * 33], s[5 * 33]); o.w = pk2(s[6 * 33], s[7 * 33]);
        *(GAS v4u*)(WT + (size_t)(n0 + n) * ldt + koff + k0 + 8 * c) = o; }
    LDS_WAIT(); asm volatile("" ::: "memory");
}

__device__ __forceinline__ void scaled_copy_item(const float* W, const float* kscale, bf16* O, int item, int lane) {
    f32x4 wv[8];
#pragma unroll
    for (int i = 0; i < 8; ++i) wv[i] = __builtin_nontemporal_load((const f32x4*)(W + (size_t)(2 * item + (i >> 2)) * 1024) + lane + 64 * (i & 3));
#pragma unroll
    for (int i = 0; i < 8; ++i) { const f32x4 v = wv[i] * kscale[2 * item + (i >> 2)];
        *(GAS unsigned long long*)(O + (size_t)(2 * item + (i >> 2)) * 1024 + 4 * (lane + 64 * (i & 3))) = (unsigned long long)pk2(v[0], v[1]) | ((unsigned long long)pk2(v[2], v[3]) << 32); }
}

__device__ __forceinline__ void late_weight_copies(const Ctx& F, int wgi, int nwg) {
    PHASE_TID();
    LAS float* scr = (LAS float*)(F.lds + wave * 16384);
    bf16* WQ = (bf16*)(F.ws + WS_WQ); bf16* WO = (bf16*)(F.ws + WS_WO); bf16* WUP = (bf16*)(F.ws + WS_WUP); bf16* WDN = (bf16*)(F.ws + WS_WDN);
    constexpr int I_SQ = 16 * 32, I_UP = 16 * 128, I_DN = 64 * 32, NITEMS = 2 * I_SQ + I_UP + I_DN;
    for (int it = wgi * NWAVES + wave; it < NITEMS; it += nwg * NWAVES) {
        int r = it;
        if (r < I_SQ) { scaled_copy_item(F.w_xq, F.g_xa, WQ, r, lane); continue; } r -= I_SQ;
        if (r < I_SQ) { transpose_item(F.w_xo, 1024, 32, nullptr, WO, 1024, 0, scr, r, lane); continue; } r -= I_SQ;
        if (r < I_UP) { transpose_item(F.w_up, 4096, 128, F.g_mlp, WUP, 1024, 0, scr, r, lane); continue; } r -= I_UP;
        transpose_item(F.w_down, 1024, 32, nullptr, WDN, 4096, 0, scr, r, lane);
    }
}

__device__ __forceinline__ void p0_prologue(const Ctx& F) {
    PHASE_TID();
    LAS float* scr = (LAS float*)(F.lds + wave * 16384);
    const int gw = F.vcu * NWAVES + wave, NGW = F.G * NWAVES;
    { for (int k = tid; k < 1024; k += NWAVES * 64) { const f32x4* p = (const f32x4*)(F.w_in + (size_t)k * INCOLS + NPROJ); const f32x4 a = p[0], b = p[1];
          LAS f32x4* d = (LAS f32x4*)(F.lds + (k >> 7) * 16384 + 12288 + (k & 127) * 32); d[0] = a; d[1] = b; }
      __syncthreads(); }
    bf16* WIN = (bf16*)(F.ws + WS_WIN); bf16* WOUT = (bf16*)(F.ws + WS_WOUT); bf16* WK = (bf16*)(F.ws + WS_WK);
    bf16* WV = (bf16*)(F.ws + WS_WV);
    constexpr int I_IN = 16 * 80, I_OUT = 8 * 32, I_SQ = 16 * 32;
    constexpr int NITEMS = I_IN + I_OUT + 2 * I_SQ;
    for (int it = gw; it < NITEMS; it += NGW) {
        int r = it;
        if (r < I_IN) { transpose_item(F.w_in, INCOLS, 80, F.g_mix, WIN, 1024, 0, scr, r, lane); continue; } r -= I_IN;
        if (r < I_OUT) { transpose_item(F.w_out + (size_t)512 * 1024, 1024, 32, nullptr, WOUT, 1024, 512, scr, r, lane); continue; } r -= I_OUT;
        if (r < I_SQ) { transpose_item(F.w_xk, 1024, 32, nullptr, WK, 1024, 0, scr, r, lane); continue; } r -= I_SQ;
        transpose_item(F.w_xv, 1024, 32, nullptr, WV, 1024, 0, scr, r, lane);
    }
    if (wave == 0)
    for (int tile = F.vcu; tile < 256; tile += F.G) {
        const int g = tile >> 6, n = 64 * ((tile >> 2) & 15) + 4 * (lane & 15), c = 32 * (tile & 3) + 8 * (lane >> 4);
        f32x4 acc[8];
#pragma unroll
        for (int j = 0; j < 8; ++j) acc[j] = (f32x4){0.f, 0.f, 0.f, 0.f};
        const float* wo = F.w_out + (size_t)(g * 128) * 1024 + n; const float* wp = F.w_pool + (size_t)(g * 128 + c) * 128; const float* ps = F.pool_scale + g * 128;
#pragma unroll 2
        for (int d = 0; d < 128; d += 4) {
            f32x4 w4[4], p4[8]; const f32x4 s4 = *(const f32x4*)(ps + d);
#pragma unroll
            for (int dd = 0; dd < 4; ++dd) w4[dd] = *(const f32x4*)(wo + (size_t)(d + dd) * 1024);
#pragma unroll
            for (int j = 0; j < 8; ++j) p4[j] = *(const f32x4*)(wp + j * 128 + d);
#pragma unroll
            for (int dd = 0; dd < 4; ++dd) { const f32x4 ws = w4[dd] * s4[dd];
#pragma unroll
                for (int j = 0; j < 8; ++j) acc[j] += ws * p4[j][dd]; }
        }
#pragma unroll
        for (int i = 0; i < 4; ++i) { v4u o; o.x = pk2(acc[0][i], acc[1][i]); o.y = pk2(acc[2][i], acc[3][i]); o.z = pk2(acc[4][i], acc[5][i]); o.w = pk2(acc[6][i], acc[7][i]);
            *(GAS v4u*)(WOUT + (size_t)(n + i) * 1024 + g * 128 + c) = o; }
    }
    {
        float wba[16][8];
#pragma unroll
        for (int j = 0; j < 4; ++j)
#pragma unroll
            for (int i = 0; i < 4; ++i) { const int k = 4 * lane + 256 * j + i; const LAS f32x4* p = (const LAS f32x4*)(F.lds + (k >> 7) * 16384 + 12288 + (k & 127) * 32); const f32x4 a = p[0], b = p[1];
                wba[j * 4 + i][0] = a[0]; wba[j * 4 + i][1] = a[1]; wba[j * 4 + i][2] = a[2]; wba[j * 4 + i][3] = a[3]; wba[j * 4 + i][4] = b[0]; wba[j * 4 + i][5] = b[1]; wba[j * 4 + i][6] = b[2]; wba[j * 4 + i][7] = b[3]; }
        f32x4 gv[4];
#pragma unroll
        for (int j = 0; j < 4; ++j) gv[j] = ((const f32x4*)F.g_mix)[lane + 64 * j];
        bf16* XN = (bf16*)(F.ws + WS_A); float* BA = (float*)(F.ws + WS_BA);
        const unsigned rowctr_a = (unsigned)(uintptr_t)(F.lds + MISC_OFF + 64);
        for (;;) {
            unsigned kq; asm volatile("ds_add_rtn_u32 %0, %1, %2\n\ts_waitcnt lgkmcnt(0)" : "=v"(kq) : "v"(rowctr_a), "v"(lane == 0 ? 1u : 0u) : "memory");
            const int m = F.vcu + (int)__builtin_amdgcn_readfirstlane(kq) * F.G; if (m >= M) break;
            const GAS f32x4* xr = (const GAS f32x4*)(F.x + (size_t)m * D) + lane;
            f32x4 v[4]; float s = 0.f;
#pragma unroll
            for (int j = 0; j < 4; ++j) { v[j] = __builtin_nontemporal_load(xr + 64 * j); s += (v[j][0] * v[j][0] + v[j][1] * v[j][1]) + (v[j][2] * v[j][2] + v[j][3] * v[j][3]); }
            const float ssx = wave_sum(s);
            const float rs = __builtin_amdgcn_rsqf(ssx * (1.0f / D) + pg8::RMS_EPS);
            GAS unsigned long long* o8 = (GAS unsigned long long*)(XN + (size_t)m * D) + lane;
            float dsum[8];
#pragma unroll
            for (int c = 0; c < 8; ++c) dsum[c] = 0.f;
#pragma unroll
            for (int j = 0; j < 4; ++j) {
                o8[64 * j] = (unsigned long long)pk2(v[j][0], v[j][1]) | ((unsigned long long)pk2(v[j][2], v[j][3]) << 32);
                v[j] = v[j] * rs * gv[j];
#pragma unroll
                for (int i = 0; i < 4; ++i)
#pragma unroll
                    for (int c = 0; c < 8; ++c) dsum[c] += v[j][i] * wba[j * 4 + i][c]; }
#pragma unroll
            for (int c = 0; c < 8; ++c) dsum[c] = wave_sum(dsum[c]);
            if (lane == 0) { ((float*)(F.ws + WS_SSQ0))[m] = ssx; *(GAS f32x4*)(BA + (size_t)m * 8) = (f32x4){dsum[0], dsum[1], dsum[2], dsum[3]}; *(GAS f32x4*)(BA + (size_t)m * 8 + 4) = (f32x4){dsum[4], dsum[5], dsum[6], dsum[7]}; }
        }
    }
    {
        f32x4 gv[4];
#pragma unroll
        for (int j = 0; j < 4; ++j) gv[j] = ((const f32x4*)F.g_mem)[lane + 64 * j];
        bf16* MN = (bf16*)(F.ws + WS_MN);
        for (int m = gw; m < MROWS; m += NGW) {
            const GAS f32x4* xr = (const GAS f32x4*)(F.mem + (size_t)m * D) + lane;
            f32x4 v[4]; float s = 0.f;
#pragma unroll
            for (int j = 0; j < 4; ++j) { v[j] = __builtin_nontemporal_load(xr + 64 * j); s += (v[j][0] * v[j][0] + v[j][1] * v[j][1]) + (v[j][2] * v[j][2] + v[j][3] * v[j][3]); }
            const float rs = __builtin_amdgcn_rsqf(wave_sum(s) * (1.0f / D) + pg8::RMS_EPS);
            GAS unsigned long long* o8 = (GAS unsigned long long*)(MN + (size_t)m * D) + lane;
#pragma unroll
            for (int j = 0; j < 4; ++j) { v[j] = v[j] * rs * gv[j]; o8[64 * j] = (unsigned long long)pk2(v[j][0], v[j][1]) | ((unsigned long long)pk2(v[j][2], v[j][3]) << 32); }
        }
    }
}

typedef short bf16x8v __attribute__((ext_vector_type(8)));
__device__ __forceinline__ f32x4 mfma16(bf16x8v x, bf16x8v y, f32x4 c) { return __builtin_amdgcn_mfma_f32_16x16x32_bf16(x, y, c, 0, 0, 0); }
constexpr int GA_QB = 0, GA_KB = 17408, GA_VB = 34816, GA_LM = 51200, GA_GC = 67584, GA_BT = GA_GC + 256, GA_EG = GA_BT + 256, GA_ED = GA_EG + 256;
constexpr int GA_SZ = GA_ED + 256;
constexpr int GQS = 136;
__device__ __forceinline__ v4u pack8(const float (&f)[8]) { v4u o; o.x = pk2(f[0], f[1]); o.y = pk2(f[2], f[3]); o.z = pk2(f[4], f[5]); o.w = pk2(f[6], f[7]); return o; }
__device__ __forceinline__ float bf2f(unsigned short h) { return __builtin_bit_cast(float, (unsigned)h << 16); }

template <int J, int H> struct SubHalf { static constexpr int G0 = (J + 1) >> 2, GLO = H ? (G0 > 8 ? G0 : 8) : (G0 < 8 ? G0 : 8), GHI = H ? 16 : 8, N = GHI - GLO; };
template <int J, int H> __device__ __forceinline__ void subst_load(f32x4 (&l)[8], const LAS float* LTv) {
    if constexpr (J < 63) {
        using P = SubHalf<J, H>;
#pragma unroll
        for (int g = 0; g < P::N; ++g) l[g] = *(const LAS f32x4*)(LTv + J * 64 + 4 * (P::GLO + g));
    }
}
typedef float f32x2v_ __attribute__((ext_vector_type(2)));
template <int J, int H> __device__ __forceinline__ void subst_fma(f32x2v_ (&R)[64], const f32x4 (&l)[8], const f32x2v_ x) {
    using P = SubHalf<J, H>;
#pragma unroll
    for (int g = 0; g < P::N; ++g)
#pragma unroll
        for (int e = 0; e < 4; ++e) { const int i = 4 * (P::GLO + g) + e; if (i > J) { const float lv = l[g][e]; R[i] = __builtin_elementwise_fma((f32x2v_){-lv, -lv}, x, R[i]); } }
}
template <int J> __device__ __forceinline__ void subst_step(f32x2v_ (&R)[64], f32x4 (&la)[8], f32x4 (&lb)[8], const LAS float* LTv) {
    const f32x2v_ x = R[J];
    subst_load<J, 1>(lb, LTv);
    subst_fma<J, 0>(R, la, x);
    __builtin_amdgcn_sched_barrier(0);
    subst_load<J + 1, 0>(la, LTv);
    subst_fma<J, 1>(R, lb, x);
    __builtin_amdgcn_sched_barrier(0);
}
template <int... Js> __device__ __forceinline__ void subst_all(f32x2v_ (&R)[64], f32x4 (&la)[8], f32x4 (&lb)[8], const LAS float* LTv, std::integer_sequence<int, Js...>) {
    (subst_step<Js>(R, la, lb, LTv), ...);
}

constexpr int GA_TB = 2 * GA_SZ;
static_assert(GA_TB + 4096 <= LDSCTL_OFF, "P2a LDS map");
__device__ __forceinline__ void p2a_tables(const Ctx& F, int pr, int tboff, int t128, const float* BA, float* GL) {
    if (t128 >= 0 && t128 < 128) {
        const int ch0 = 2 * pr, bh = ch0 >> 5, chunk0 = ch0 & 31, b = bh >> 2, h = bh & 3, p = t128 >> 6, t = t128 & 63;
        const size_t row0 = (size_t)b * SEQ + chunk0 * CHUNK;
        LAS float* gcs = (LAS float*)(F.lds + tboff + p * 1024);
        const float bb = BA[(row0 + t128) * 8 + h], aa = BA[(row0 + t128) * 8 + 4 + h] + F.dt_bias[h];
        const float sp = aa > 20.f ? aa : __logf(1.0f + __expf(aa));
        float gc = -__expf(F.a_log[h]) * sp;
#pragma unroll
        for (int o = 1; o < 64; o <<= 1) { const float tt = __builtin_bit_cast(float, __builtin_amdgcn_ds_bpermute(((t - o) & 63) << 2, __builtin_bit_cast(int, gc))); if (t >= o) gc += tt; }
        const float g63 = __builtin_bit_cast(float, __builtin_amdgcn_readlane(__builtin_bit_cast(int, gc), 63));
        gcs[t] = gc; gcs[64 + t] = 1.0f / (1.0f + __expf(-bb)); gcs[128 + t] = __expf(gc); gcs[192 + t] = __expf(g63 - gc);
        if (t == 63) GL[ch0 + p] = __expf(gc);
    }
}

#define P2A_LBAR() do { asm volatile("s_waitcnt lgkmcnt(0)" ::: "memory"); __builtin_amdgcn_s_barrier(); asm volatile("" ::: "memory"); } while (0)
__device__ __forceinline__ void p2a_prep_block(const Ctx& F, const int pr, const int tboff, const int tbk, const int cg, const bf16* PROJ, bf16* QG) {
    const int ch0 = 2 * pr, bh = ch0 >> 5, chunk0 = ch0 & 31, b = bh >> 2, h = bh & 3;
    const size_t row0 = (size_t)b * SEQ + chunk0 * CHUNK;
    const int p = tbk >> 4, tl0 = (4 * tbk) & 63, tok0 = chunk0 * CHUNK + 4 * tbk; const size_t rowb = row0 + 4 * tbk;
    LAS bf16* Qb = (LAS bf16*)(F.lds + p * GA_SZ + GA_QB); LAS bf16* Kb = (LAS bf16*)(F.lds + p * GA_SZ + GA_KB); LAS bf16* Vb = (LAS bf16*)(F.lds + p * GA_SZ + GA_VB);
    const LAS float* egs = (const LAS float*)(F.lds + tboff + p * 1024 + 512);
    v4u raw[3][7];
#pragma unroll
    for (int ty = 0; ty < 3; ++ty)
#pragma unroll
        for (int r = 0; r < 7; ++r) { const bool ok = tok0 - 3 + r >= 0; const size_t rr = ok ? rowb - 3 + r : rowb;
            v4u w = __builtin_nontemporal_load((const GAS v4u*)(PROJ + rr * NPROJ + 512 + 512 * ty + h * 128 + cg * 8));
            if (!ok) w = (v4u){0u, 0u, 0u, 0u};
            raw[ty][r] = w; }
    __builtin_amdgcn_sched_barrier(0);
    v4u qgp[4];
#pragma unroll
    for (int ty = 0; ty < 3; ++ty) {
        float wt[4][8], res[4][8];
#pragma unroll
        for (int i = 0; i < 4; ++i) { const f32x4* pw = (const f32x4*)(F.conv_w + (size_t)i * 1536 + 512 * ty + h * 128 + cg * 8); const f32x4 a0 = pw[0], a1 = pw[1];
#pragma unroll
            for (int e = 0; e < 4; ++e) { wt[i][e] = a0[e]; wt[i][4 + e] = a1[e]; } }
#pragma unroll
        for (int e = 0; e < 4; ++e)
#pragma unroll
            for (int c = 0; c < 8; ++c) res[e][c] = 0.f;
#pragma unroll
        for (int r = 0; r < 7; ++r) { float f[8]; unpack8(raw[ty][r], f);
#pragma unroll
            for (int e = 0; e < 4; ++e) { const int i = r - e; if (i >= 0 && i < 4) {
#pragma unroll
                    for (int c = 0; c < 8; ++c) res[e][c] += wt[i][c] * f[c]; } } }
#pragma unroll
        for (int e = 0; e < 4; ++e) { const int t = tl0 + e;
            float ss = 0.f;
#pragma unroll
            for (int c = 0; c < 8; ++c) { res[e][c] = silu_f(res[e][c]); ss += res[e][c] * res[e][c]; }
            if (ty == 0) { ss = row16_sum(ss); const float rq = __builtin_amdgcn_rsqf(ss + 1e-6f) * 0.08838834764831845f, eg = egs[t];     float qg[8];
#pragma unroll
                for (int c = 0; c < 8; ++c) { res[e][c] *= rq; qg[c] = res[e][c] * eg; }
                *(LAS v4u*)(Qb + t * GQS + cg * 8) = pack8(res[e]); qgp[e] = pack8(qg); }
            else if (ty == 1) { ss = row16_sum(ss); const float rk = __builtin_amdgcn_rsqf(ss + 1e-6f);
#pragma unroll
                for (int c = 0; c < 8; ++c) res[e][c] *= rk;
                *(LAS v4u*)(Kb + t * GQS + cg * 8) = pack8(res[e]); }
            else *(LAS v4u*)(Vb + t * 128 + cg * 8) = pack8(res[e]);
        }
    }
#pragma unroll
    for (int e = 0; e < 4; ++e) *(GAS v4u*)(QG + (size_t)(ch0 + p) * 8192 + (tl0 + e) * 128 + cg * 8) = qgp[e];
}
__device__ __forceinline__ void p2a_tiles(const Ctx& F, const int pr, const int tboff, const int wave, const int r16, const int q4, bf16* AM) {
    const int ch0 = 2 * pr;
    for (int job = wave; job < 20; job += NWAVES) {
        const int p = job >= 10 ? 1 : 0, idx = job - 10 * p;
        const LAS bf16* Qb = (const LAS bf16*)(F.lds + p * GA_SZ + GA_QB); const LAS bf16* Kb = (const LAS bf16*)(F.lds + p * GA_SZ + GA_KB);
        LAS float* LT = (LAS float*)(F.lds + p * GA_SZ + GA_LM); const LAS float* gcs = (const LAS float*)(F.lds + tboff + p * 1024); const LAS float* bts = gcs + 64;
        const int ti = idx < 1 ? 0 : (idx < 3 ? 1 : (idx < 6 ? 2 : 3)), tj = idx - (ti * (ti + 1)) / 2;
        f32x4 accL = (f32x4){0.f, 0.f, 0.f, 0.f}, accA = accL;
#pragma unroll
        for (int s = 0; s < 4; ++s) { const bf16x8v ki = *(const LAS bf16x8v*)(Kb + (16 * ti + r16) * GQS + 32 * s + 8 * q4); const bf16x8v kj = *(const LAS bf16x8v*)(Kb + (16 * tj + r16) * GQS + 32 * s + 8 * q4);
            const bf16x8v qi = *(const LAS bf16x8v*)(Qb + (16 * ti + r16) * GQS + 32 * s + 8 * q4);
            accL = mfma16(ki, kj, accL);
            accA = mfma16(kj, qi, accA); }
        { const int j = 16 * tj + r16, i0 = 16 * ti + 4 * q4; const float gj = gcs[j];
          float val[4];
#pragma unroll
          for (int r = 0; r < 4; ++r) { const int i = i0 + r; const float e = __expf(fminf(gcs[i] - gj, 0.f)); val[r] = (j < i) ? bts[i] * accL[r] * e : 0.f; }
          *(LAS f32x4*)(LT + j * 64 + i0) = (f32x4){val[0], val[1], val[2], val[3]}; }
        { const int i = 16 * ti + r16, j0 = 16 * tj + 4 * q4; const float gi = gcs[i];
          float val[4];
#pragma unroll
          for (int r = 0; r < 4; ++r) { const int j = j0 + r; const float e = __expf(fminf(gi - gcs[j], 0.f)); val[r] = (j <= i) ? accA[r] * e : 0.f; }
          v2u w; w.x = pk2(val[0], val[1]); w.y = pk2(val[2], val[3]); *(GAS v2u*)(AM + (size_t)(ch0 + p) * 4096 + i * 64 + j0) = w; }
    }
    for (int job = NWAVES - 1 - wave; job < 12; job += NWAVES) {
        const int p = job >= 6 ? 1 : 0, u = job - 6 * p;
        const int ti = u < 3 ? 0 : (u < 5 ? 1 : 2), tj = u < 3 ? u + 1 : (u < 5 ? u - 1 : 3);
        *(GAS v2u*)(AM + (size_t)(ch0 + p) * 4096 + (16 * ti + r16) * 64 + 16 * tj + 4 * q4) = (v2u){0u, 0u};
    }
}

__device__ __forceinline__ void p2a_gdn_chunks(const Ctx& F) {
    PHASE_TID();
#define P2A_WS(name) unsigned char* name = F.ws; asm volatile("" : "+s"(name))
    constexpr int NPAIR = BATCH * DNH * (SEQ / CHUNK) / 2;
    const int tid0 = tid;
    const bool solver = wave < 4;
    if (F.vcu >= NPAIR) return;
    { P2A_WS(w0); p2a_tables(F, F.vcu, GA_TB, tid0, (const float*)(w0 + WS_BA), (float*)(w0 + WS_GGL)); }
    __syncthreads();
    { P2A_WS(w0); int tl_ = tid0; asm volatile("" : "+v"(tl_)); p2a_prep_block(F, F.vcu, GA_TB, tl_ >> 4, tl_ & 15, (const bf16*)(w0 + WS_C), (bf16*)(w0 + WS_GQG)); }
    __syncthreads();
    { P2A_WS(w0); int tl_ = tid0; asm volatile("" : "+v"(tl_)); p2a_tiles(F, F.vcu, GA_TB, wave, tl_ & 15, (tl_ & 63) >> 4, (bf16*)(w0 + WS_GAM)); }
    __syncthreads();
    int itn = 0;
    for (int pr = F.vcu; pr < NPAIR; pr += F.G, ++itn) {
        const int tb_off = GA_TB + (itn & 1) * 2048, tb_nxt = GA_TB + ((itn + 1) & 1) * 2048;
        const bool has_next = pr + F.G < NPAIR;
        const int ch0 = 2 * pr;
        int t3_ = tid0; asm volatile("" : "+v"(t3_));
        if (solver) {
            const int p = t3_ >> 7, c = t3_ & 127;
            const LAS bf16* Kb = (const LAS bf16*)(F.lds + p * GA_SZ + GA_KB); const LAS bf16* Vb = (const LAS bf16*)(F.lds + p * GA_SZ + GA_VB);
            LAS bf16* Wl = (LAS bf16*)(F.lds + p * GA_SZ + GA_LM);
            unsigned lmv = (unsigned)(size_t)(F.lds + p * GA_SZ + GA_LM), gcv = (unsigned)(size_t)(F.lds + tb_off + p * 1024); asm volatile("" : "+v"(lmv), "+v"(gcv));
            const LAS float* LTv = (const LAS float*)lmv; const LAS float* btv = (const LAS float*)(gcv + 256); const LAS float* egv = (const LAS float*)(gcv + 512); const LAS float* edv = (const LAS float*)(gcv + 768);
            const size_t chp = (size_t)(ch0 + p);
            P2A_WS(w1); bf16* KDT = (bf16*)(w1 + WS_GKD);
            f32x2v_ R[64];
#pragma unroll
            for (int g8 = 0; g8 < 8; ++g8) { float kd[8];
                f32x4 bt4[2], eg4[2], ed4[2];
#pragma unroll
                for (int hh = 0; hh < 2; ++hh) { bt4[hh] = *(const LAS f32x4*)(btv + 8 * g8 + 4 * hh); eg4[hh] = *(const LAS f32x4*)(egv + 8 * g8 + 4 * hh); ed4[hh] = *(const LAS f32x4*)(edv + 8 * g8 + 4 * hh); }
#pragma unroll
                for (int e = 0; e < 8; ++e) { const int i = 8 * g8 + e; const float bt = bt4[e >> 2][e & 3], kv = bf2f(Kb[i * GQS + c]);
                    R[i] = (f32x2v_){bt * bf2f(Vb[i * 128 + c]), bt * eg4[e >> 2][e & 3] * kv}; kd[e] = kv * ed4[e >> 2][e & 3];
                    asm volatile("" : "+v"(R[i])); }
                *(GAS v4u*)(KDT + chp * 8192 + (g8 * 128 + c) * 8) = pack8(kd);
                __builtin_amdgcn_sched_barrier(0); }
            P2A_LBAR();
            f32x4 la[8], lb[8];
            subst_load<0, 0>(la, LTv);
            subst_all(R, la, lb, LTv, std::make_integer_sequence<int, 63>{});
            P2A_LBAR();
            P2A_WS(w3); bf16* UT = (bf16*)(w3 + WS_GUT);
#pragma unroll
            for (int g8 = 0; g8 < 8; ++g8) { v4u o; o.x = pk2(R[8 * g8].x, R[8 * g8 + 1].x); o.y = pk2(R[8 * g8 + 2].x, R[8 * g8 + 3].x); o.z = pk2(R[8 * g8 + 4].x, R[8 * g8 + 5].x); o.w = pk2(R[8 * g8 + 6].x, R[8 * g8 + 7].x);
                *(GAS v4u*)(UT + chp * 8192 + (g8 * 128 + c) * 8) = o; }
#pragma unroll
            for (int i = 0; i < 64; ++i) Wl[i * 128 + c] = (bf16)f2bf(-R[i].y);
        } else {
            const int tp = t3_ - 256;
            if (has_next) { P2A_WS(w1); p2a_tables(F, pr + F.G, tb_nxt, tp, (const float*)(w1 + WS_BA), (float*)(w1 + WS_GGL)); }
            P2A_LBAR();
            if (has_next) {
#pragma unroll 1
                for (int pass = 0; pass < 2; ++pass) { P2A_WS(w2); int tq_ = tp; asm volatile("" : "+v"(tq_));
                    p2a_prep_block(F, pr + F.G, tb_nxt, (tq_ >> 4) + 16 * pass, tq_ & 15, (const bf16*)(w2 + WS_C), (bf16*)(w2 + WS_GQG)); }
            }
            P2A_LBAR();
        }
        P2A_LBAR();
        { P2A_WS(w4); bf16* WM = (bf16*)(w4 + WS_GWM); int tl_ = tid0; asm volatile("" : "+v"(tl_));
#pragma unroll
          for (int k = 0; k < 4; ++k) { const int idx = tl_ + 512 * k, p = idx >> 10, id = idx & 1023;
              *(GAS v4u*)(WM + (size_t)(ch0 + p) * 8192 + id * 8) = *(const LAS v4u*)((const LAS bf16*)(F.lds + p * GA_SZ + GA_LM) + id * 8); } }
        P2A_LBAR();
        if (has_next) { P2A_WS(w5); int tl_ = tid0; asm volatile("" : "+v"(tl_)); p2a_tiles(F, pr + F.G, tb_nxt, wave, tl_ & 15, (tl_ & 63) >> 4, (bf16*)(w5 + WS_GAM)); }
        P2A_LBAR();
    }
}
#undef P2A_WS
#undef P2A_LBAR

__device__ __forceinline__ void p2b_gdn_scan(const Ctx& F) {
    PHASE_TID();
    constexpr int STS = 136, VNS = 72;
    constexpr int OP0 = 32 * STS * 2 + 32 * VNS * 2;
    constexpr int O_WM = 0, O_QG = 64 * 272, O_AM = 2 * 64 * 272, O_KD = O_AM + 64 * 144, OPB = O_KD + 128 * 144;
    static_assert(OP0 + 2 * OPB <= LDSCTL_OFF, "scan LDS map");
    LAS bf16* ST = (LAS bf16*)F.lds; LAS bf16* VN = (LAS bf16*)(F.lds + 32 * STS * 2);
    const bf16* WM = (const bf16*)(F.ws + WS_GWM); const bf16* UT = (const bf16*)(F.ws + WS_GUT); const bf16* QG = (const bf16*)(F.ws + WS_GQG); const bf16* KDT = (const bf16*)(F.ws + WS_GKD);
    const bf16* AM = (const bf16*)(F.ws + WS_GAM); const float* GL = (const float*)(F.ws + WS_GGL); bf16* OR = (bf16*)(F.ws + WS_OR);
    const int q4 = lane >> 4, r16 = lane & 15, it_ = wave >> 1, dt = wave & 1;
    struct Stage { v4u g[7]; v2u ut; float gl; };
    unsigned lw[7];
#pragma unroll
    for (int k = 0; k < 2; ++k) { const int i = tid + 512 * k; lw[k] = O_WM + (i >> 4) * 272 + (i & 15) * 16; lw[2 + k] = O_QG + (i >> 4) * 272 + (i & 15) * 16; lw[5 + k] = O_KD + (i & 127) * 144 + (i >> 7) * 16; }
    lw[4] = O_AM + (tid >> 3) * 144 + (tid & 7) * 16;
    for (int item = F.vcu; item < BATCH * DNH * 4; item += F.G) {
        const int b = item >> 4, h = (item >> 2) & 3, dvq = item & 3;
        const int ch0 = (b * 4 + h) * 32;
        for (int idx = tid; idx < 32 * STS / 2; idx += NWAVES * 64) ((LAS unsigned*)ST)[idx] = 0u;
        f32x4 Sacc[2]; Sacc[0] = (f32x4){0.f, 0.f, 0.f, 0.f}; Sacc[1] = Sacc[0];
#define GDN_ISSUE(S, chx) do { const size_t cb = (size_t)(chx); \
            _Pragma("unroll") for (int k = 0; k < 2; ++k) { (S).g[k] = *(const GAS v4u*)(WM + cb * 8192 + (size_t)(tid + 512 * k) * 8); (S).g[2 + k] = *(const GAS v4u*)(QG + cb * 8192 + (size_t)(tid + 512 * k) * 8); \
                (S).g[5 + k] = *(const GAS v4u*)(KDT + cb * 8192 + (size_t)(tid + 512 * k) * 8); } \
            (S).g[4] = *(const GAS v4u*)(AM + cb * 4096 + (size_t)tid * 8); \
            (S).ut = *(const GAS v2u*)(UT + cb * 8192 + ((2 * it_ + (q4 >> 1)) * 128 + dvq * 32 + 16 * dt + r16) * 8 + 4 * (q4 & 1)); (S).gl = GL[cb]; } while (0)
#define GDN_WRITE(S, buf) do { _Pragma("unroll") for (int k = 0; k < 7; ++k) *(LAS v4u*)(F.lds + OP0 + (buf) * OPB + lw[k]) = (S).g[k]; } while (0)
#define GDN_LBAR() do { asm volatile("s_waitcnt lgkmcnt(0)" ::: "memory"); __builtin_amdgcn_s_barrier(); asm volatile("" ::: "memory"); } while (0)
        Stage S0, S1, S2;
        GDN_ISSUE(S0, ch0); GDN_ISSUE(S1, ch0 + 1); GDN_ISSUE(S2, ch0 + 2); GDN_WRITE(S0, 0);
        GDN_LBAR();
#define GDN_STEP(SC, SW, cc) do { const int c = (cc); const int bufc = c & 1; \
            const v2u utc = (SC).ut; const float glc = (SC).gl; \
            { const int cl = (c + 3 < SEQ / CHUNK) ? c + 3 : SEQ / CHUNK - 1; GDN_ISSUE(SC, ch0 + cl); } \
            const LAS unsigned char* ob = F.lds + OP0 + bufc * OPB; \
            bf16x8v sf[4], wf[4], qf[4]; \
            _Pragma("unroll") for (int s = 0; s < 4; ++s) { sf[s] = *(const LAS bf16x8v*)(ST + (16 * dt + r16) * STS + 32 * s + 8 * q4); \
                wf[s] = *(const LAS bf16x8v*)(ob + O_WM + (16 * it_ + r16) * 272 + (32 * s + 8 * q4) * 2); qf[s] = *(const LAS bf16x8v*)(ob + O_QG + (16 * it_ + r16) * 272 + (32 * s + 8 * q4) * 2); } \
            f32x4 vacc = (f32x4){bflo(utc.x), bfhi(utc.x), bflo(utc.y), bfhi(utc.y)}; \
            f32x4 oacc = (f32x4){0.f, 0.f, 0.f, 0.f}; \
            _Pragma("unroll") for (int s = 0; s < 4; ++s) { vacc = mfma16(wf[s], sf[s], vacc); oacc = mfma16(sf[s], qf[s], oacc); } \
            { v2u w; w.x = pk2(vacc[0], vacc[1]); w.y = pk2(vacc[2], vacc[3]); *(LAS v2u*)(VN + (16 * dt + r16) * VNS + 16 * it_ + 4 * q4) = w; } \
            GDN_LBAR(); \
            bf16x8v vf[2][2], af[2], kf[2]; \
            _Pragma("unroll") for (int s = 0; s < 2; ++s) { af[s] = *(const LAS bf16x8v*)(ob + O_AM + (16 * it_ + r16) * 144 + (32 * s + 8 * q4) * 2); kf[s] = *(const LAS bf16x8v*)(ob + O_KD + (16 * wave + r16) * 144 + (32 * s + 8 * q4) * 2); } \
            _Pragma("unroll") for (int t = 0; t < 2; ++t) _Pragma("unroll") for (int s = 0; s < 2; ++s) vf[t][s] = *(const LAS bf16x8v*)(VN + (16 * t + r16) * VNS + 32 * s + 8 * q4); \
            _Pragma("unroll") for (int s = 0; s < 2; ++s) { const bf16x8v vo = *(const LAS bf16x8v*)(VN + (16 * dt + r16) * VNS + 32 * s + 8 * q4); oacc = mfma16(vo, af[s], oacc); } \
            { v2u w; w.x = pk2(oacc[0], oacc[1]); w.y = pk2(oacc[2], oacc[3]); *(GAS v2u*)(OR + ((size_t)b * SEQ + c * CHUNK + 16 * it_ + r16) * DNW + h * 128 + dvq * 32 + 16 * dt + 4 * q4) = w; } \
            _Pragma("unroll") for (int t = 0; t < 2; ++t) { Sacc[t] = Sacc[t] * glc; \
                _Pragma("unroll") for (int s = 0; s < 2; ++s) Sacc[t] = mfma16(kf[s], vf[t][s], Sacc[t]); \
                v2u w; w.x = pk2(Sacc[t][0], Sacc[t][1]); w.y = pk2(Sacc[t][2], Sacc[t][3]); *(LAS v2u*)(ST + (16 * t + r16) * STS + 16 * wave + 4 * q4) = w; } \
            GDN_WRITE(SW, bufc ^ 1); \
            GDN_LBAR(); \
        } while (0)
#pragma unroll 1
        for (int c3 = 0; c3 < SEQ / CHUNK; c3 += 3) { GDN_STEP(S0, S1, c3); if (c3 + 1 < SEQ / CHUNK) GDN_STEP(S1, S2, c3 + 1); if (c3 + 2 < SEQ / CHUNK) GDN_STEP(S2, S0, c3 + 2); }
#undef GDN_STEP
#undef GDN_LBAR
#undef GDN_WRITE
#undef GDN_ISSUE
    }
}

__device__ __forceinline__ void p3_mixer_finish(const Ctx& F) {
    PHASE_TID();
    const int gw = F.vcu * NWAVES + wave, NGW = F.G * NWAVES;
    const bf16* PROJ = (const bf16*)(F.ws + WS_C); const bf16* OR = (const bf16*)(F.ws + WS_OR); bf16* Y = (bf16*)(F.ws + WS_Y);
    const int c0 = lane * 8, grp = lane >> 4, win = 2 << grp;
    float gn[8];
    { const f32x4* p = (const f32x4*)(F.g_dn + (c0 & 127)); const f32x4 a = p[0], b = p[1];
#pragma unroll
      for (int e = 0; e < 4; ++e) { gn[e] = a[e]; gn[4 + e] = b[e]; } }
    auto emit = [&](const int e, const float (&u0)[8], const float (&S)[8], const v4u zwe, const v4u owe, const int tk, const size_t mrow) {
        const int cnt = (tk + 1) < win ? (tk + 1) : win; const float ic = __builtin_amdgcn_rcpf((float)cnt);
        v4u o; o.x = pk2(S[0] * ic - u0[0], S[1] * ic - u0[1]); o.y = pk2(S[2] * ic - u0[2], S[3] * ic - u0[3]); o.z = pk2(S[4] * ic - u0[4], S[5] * ic - u0[5]); o.w = pk2(S[6] * ic - u0[6], S[7] * ic - u0[7]);
        *(GAS v4u*)(Y + mrow * D + c0) = o;
        float ov[8]; unpack8(owe, ov);
        float ss = 0.f;
#pragma unroll
        for (int c = 0; c < 8; ++c) ss += ov[c] * ov[c];
        ss = row16_sum(ss);
        const float rs = __builtin_amdgcn_rsqf(ss * (1.0f / 128.0f) + 1e-6f);
        float z[8]; unpack8(zwe, z);
        float y[8];
#pragma unroll
        for (int c = 0; c < 8; ++c) y[c] = ov[c] * rs * gn[c] * silu_f(z[c]);
        v4u o2; o2.x = pk2(y[0], y[1]); o2.y = pk2(y[2], y[3]); o2.z = pk2(y[4], y[5]); o2.w = pk2(y[6], y[7]);
        *(GAS v4u*)(Y + mrow * D + 512 + c0) = o2;
        (void)e;
    };
    struct Blk { v4u nw[4], od[4], zw[4], ow[4]; };
    auto issue = [&](Blk& B, const int m0, const int tok0) {
#pragma unroll
        for (int e = 0; e < 4; ++e) { B.nw[e] = *(const GAS v4u*)(PROJ + (size_t)(m0 + e) * NPROJ + c0);
            const size_t ro = (tok0 + e - win >= 0) ? (size_t)(m0 + e - win) : (size_t)m0; B.od[e] = *(const GAS v4u*)(PROJ + ro * NPROJ + c0); }
#pragma unroll
        for (int e = 0; e < 4; ++e) { B.zw[e] = __builtin_nontemporal_load((const GAS v4u*)(PROJ + (size_t)(m0 + e) * NPROJ + 2048 + c0)); B.ow[e] = __builtin_nontemporal_load((const GAS v4u*)(OR + (size_t)(m0 + e) * DNW + c0)); }
    };
    auto carry = [&](const Blk& B, float (&S)[8], const int m0, const int tok0) {
#pragma unroll
        for (int e = 0; e < 4; ++e) {
            float u0[8]; unpack8(B.nw[e], u0);
            float fs[8]; unpack8(B.od[e], fs); const bool sub = tok0 + e - win >= 0;
#pragma unroll
            for (int c = 0; c < 8; ++c) S[c] += u0[c] - (sub ? fs[c] : 0.f);
            emit(e, u0, S, B.zw[e], B.ow[e], tok0 + e, (size_t)(m0 + e));
        }
    };
    for (int seg = gw; seg < M / 16; seg += NGW) {
        float S[8];
        const int ms = seg * 16, ts = ms & (SEQ - 1);
        Blk BA, BB;
        {
            v4u hw[16];
#pragma unroll
            for (int i = 1; i <= 16; ++i) { const bool on = (i <= win) && (ts - i >= 0); const size_t rr = on ? (size_t)(ms - i) : (size_t)ms; hw[i - 1] = *(const GAS v4u*)(PROJ + rr * NPROJ + c0); }
            issue(BA, ms, ts);
            __builtin_amdgcn_sched_barrier(0);
#pragma unroll
            for (int c = 0; c < 8; ++c) S[c] = 0.f;
#pragma unroll
            for (int i = 1; i <= 16; ++i) { float f[8]; unpack8(hw[i - 1], f); const bool on = (i <= win) && (ts - i >= 0);
#pragma unroll
                for (int c = 0; c < 8; ++c) S[c] += on ? f[c] : 0.f; }
        }
        issue(BB, ms + 4, ts + 4);   __builtin_amdgcn_sched_barrier(0); carry(BA, S, ms, ts);
        issue(BA, ms + 8, ts + 8);   __builtin_amdgcn_sched_barrier(0); carry(BB, S, ms + 4, ts + 4);
        issue(BB, ms + 12, ts + 12); __builtin_amdgcn_sched_barrier(0); carry(BA, S, ms + 8, ts + 8);
        carry(BB, S, ms + 12, ts + 12);
    }
}

__device__ __forceinline__ void p10_final_norm(const Ctx& F) {
    PHASE_TID();
    const int gw = F.vcu * NWAVES + wave, NGW = F.G * NWAVES;
    f32x4 gv[4];
#pragma unroll
    for (int j = 0; j < 4; ++j) gv[j] = ((const f32x4*)F.g_fin)[lane + 64 * j];
    for (int m = gw; m < M; m += NGW) {
        GAS f32x4* xr = (GAS f32x4*)(F.out + (size_t)m * D) + lane;
        f32x4 v[4]; float s = 0.f;
#pragma unroll
        for (int j = 0; j < 4; ++j) { v[j] = xr[64 * j]; s += (v[j][0] * v[j][0] + v[j][1] * v[j][1]) + (v[j][2] * v[j][2] + v[j][3] * v[j][3]); }
        const float rs = 1.0f / sqrtf(wave_sum(s) * (1.0f / D) + pg8::RMS_EPS);
#pragma unroll
        for (int j = 0; j < 4; ++j) xr[64 * j] = v[j] * rs * gv[j];
    }
}

struct Args { const float* in[21]; float* out; unsigned char* ws; int ph_lo, ph_hi, li, pad; };
__global__ void __launch_bounds__(NWAVES * 64, 2) hymba_fwd(Args args) {
    extern __shared__ __attribute__((aligned(16))) unsigned char lds[];
    Ctx F;
    F.lds = (LAS unsigned char*)lds;
    volatile LAS unsigned* MISC = (volatile LAS unsigned*)(F.lds + MISC_OFF);
    F.G = gridDim.x; { const int bx = blockIdx.x; F.vcu = (F.G % 8 == 0) ? (bx % 8) * (F.G / 8) + bx / 8 : bx; }
    F.x = args.in[0]; F.mem = args.in[1]; F.g_mix = args.in[2]; F.w_in = args.in[3]; F.w_pool = args.in[4]; F.pool_scale = args.in[5]; F.conv_w = args.in[6]; F.a_log = args.in[7];
    F.dt_bias = args.in[8]; F.g_dn = args.in[9]; F.w_out = args.in[10]; F.g_xa = args.in[11]; F.g_mem = args.in[12]; F.w_xq = args.in[13]; F.w_xk = args.in[14]; F.w_xv = args.in[15];
    F.w_xo = args.in[16]; F.g_mlp = args.in[17]; F.w_up = args.in[18]; F.w_down = args.in[19]; F.g_fin = args.in[20];
    F.out = args.out; F.ws = args.ws;
    unsigned char* ws = args.ws;
    gu32* ctl = (gu32*)(ws + WS_CTL);
    for (int u = threadIdx.x; u < (LDS_BYTES - LDSCTL_OFF) / 4; u += NWAVES * 64) ((LAS unsigned*)(F.lds + LDSCTL_OFF))[u] = 0u;
    __syncthreads();
    XcdBarrier bar; bar.bar = (unsigned*)(ctl + CW_BAR); bar.x = 0; bar.st = nullptr;
    if (N_LAUNCHES == 1) bar = xcd_barrier_post((unsigned*)(ctl + CW_BAR), MISC + 8);
#define GRID_BAR() do { if (N_LAUNCHES == 1) { xcd_barrier(bar); if (PROBE_REP == 100) xcd_barrier(bar); } } while (0)
    const int lo = args.ph_lo, hi = args.ph_hi;
#define IN(k) (lo <= (k) && (k) < hi)
#define NREP(k) ((PROBE_REP == (k)) ? 2 : 1)
#define BOTH(k) (IN(k) && IN((k) + 1))
    using namespace pg8;
    bf16_t* WIN = (bf16_t*)(ws + WS_WIN); bf16_t* WOUT = (bf16_t*)(ws + WS_WOUT); bf16_t* WQ = (bf16_t*)(ws + WS_WQ); bf16_t* WK = (bf16_t*)(ws + WS_WK);
    bf16_t* WV = (bf16_t*)(ws + WS_WV); bf16_t* WO = (bf16_t*)(ws + WS_WO); bf16_t* WUP = (bf16_t*)(ws + WS_WUP); bf16_t* WDN = (bf16_t*)(ws + WS_WDN);
    bf16_t* MN = (bf16_t*)(ws + WS_MN); bf16_t* KM = (bf16_t*)(ws + WS_KM); bf16_t* VT = (bf16_t*)(ws + WS_VT);
    bf16_t* RA = (bf16_t*)(ws + WS_A); bf16_t* RB = (bf16_t*)(ws + WS_B); bf16_t* RC = (bf16_t*)(ws + WS_C); bf16_t* PS = (bf16_t*)(ws + WS_PS);
    float* SSQ1 = (float*)(ws + WS_SSQ1); float* SSQ2 = (float*)(ws + WS_SSQ2); float* SSQ3 = (float*)(ws + WS_SSQ3);
    const int bx = (int)blockIdx.x;

    if (IN(0)) { for (int rep = 0; rep < NREP(0); ++rep) { p0_prologue(F); __syncthreads(); } if (BOTH(0)) GRID_BAR(); }
    if (IN(1)) {
        for (int rep = 0; rep < NREP(1); ++rep) {
        { Gemm g{RA, WIN, 1024, 1024, 1024}; StaticOrder S; S.init(M, NPROJ, F.G, bx); EpiStore<0, true> E{RC, NPROJ, (const float*)(ws + WS_SSQ0)};
          gemm_phase<EpiStore<0, true>, StaticOrder, true, true>(F.lds, g, S, E); }
        { Gemm g{MN, WK, 1024, 1024, 1024}; StaticOrder S; S.init(MROWS, 1024, F.G, bx); EpiStore<0, false> E{KM, 1024, nullptr};
          gemm_phase<EpiStore<0, false>, StaticOrder, true, true>(F.lds, g, S, E); }
        { Gemm g{MN, WV, 1024, 1024, 1024}; StaticOrder S; S.init(MROWS, 1024, F.G, (bx + F.G / 2) % F.G); EpiStore<0, false> E{VT  , 1024, nullptr};
          gemm_phase<EpiStore<0, false>, StaticOrder, true, true>(F.lds, g, S, E); }
        }
        { const int q = F.G / 4; const int seg = bx / q; if ((seg & 1) && F.G % 4 == 0) late_weight_copies(F, (seg >> 1) * q + (bx - seg * q), 2 * q); else if (F.G % 4 != 0 && bx == 0) {   } }
        if (F.G % 4 != 0) late_weight_copies(F, bx, F.G);
        if (BOTH(1)) GRID_BAR();
    }
    if (IN(2)) { for (int rep = 0; rep < NREP(2); ++rep) { p2a_gdn_chunks(F); __syncthreads(); } if (BOTH(2)) GRID_BAR(); }
    if (IN(3)) { for (int rep = 0; rep < NREP(3); ++rep) { p2b_gdn_scan(F); __syncthreads(); } if (BOTH(3)) GRID_BAR(); }
    if (IN(4)) { for (int rep = 0; rep < NREP(4); ++rep) { p3_mixer_finish(F); __syncthreads(); } if (BOTH(4)) GRID_BAR(); }
    if (IN(5)) {
        for (int rep = 0; rep < NREP(5); ++rep) {
        { Gemm g{(const bf16_t*)(ws + WS_Y), WOUT, 1024, 1024, 1024}; StaticOrder S; S.init(M, D, F.G, bx); EpiResid<0> E{(const float*)RA, RB, SSQ1, nullptr, nullptr, nullptr};
          gemm_phase<EpiResid<0>, StaticOrder, true, true>(F.lds, g, S, E); }
        __syncthreads();
        for (int w = F.vcu; w < 256; w += F.G) {
            const int p = w >> 2, c = w & 3;
            constexpr long TS = 2L * 128 * 1024 * 2;
            Gemm g{KM, WQ, 1024, 1024, 256};
            PairUnits S{Unit{p, c, (long)((p >> 2) - p) * TS + (long)(p & 3) * 512, (long)(p & 3) * 512, 0},
                        Unit{64 + p, c, (long)((const char*)WO - (const char*)KM) + (long)((p & 3) - 64 - p) * TS + (long)c * 512, (long)((const char*)VT - (const char*)WQ) + (long)((p >> 2) - c) * TS + (long)c * 512, 0}, 2};
            EpiStore<0, false> E{RC  , 1024, nullptr};
            gemm_phase<EpiStore<0, false>, PairUnits, true, true>(F.lds, g, S, E);
            __syncthreads();
        }
        }
        if (BOTH(5)) GRID_BAR();
    }
    if (IN(7)) {
        for (int rep = 0; rep < NREP(7); ++rep) {
        Gemm g{RB, RC  , 1024, 1024, 1024}; BatchOrder S; S.init(M, D, F.G, bx, 1); S.bstep = 4L * 2 * 128 * 1024 * 2;
        EpiSoftmaxRow E{RA, 1024, SSQ1, 0.0625f * 1.4426950408889634f, F.lds + RING_BYTES};
        gemm_phase<EpiSoftmaxRow, BatchOrder, true, true>(F.lds, g, S, E);
        __syncthreads();
        }
        if (BOTH(7)) GRID_BAR();
    }
    if (IN(8)) {
        Gemm g{RA, RC + (size_t)16384 * 1024, 1024, 1024, 1024}; BatchOrder S; S.init(M, D, F.G, bx); S.bstep = 4L * 2 * 128 * 1024 * 2; EpiResid<1> E{nullptr, RB, SSQ2, nullptr, nullptr, nullptr};
        gemm_phase<EpiResid<1>, BatchOrder, true, true>(F.lds, g, S, E);
        if (BOTH(8)) GRID_BAR();
    }
    if (IN(9)) {
        Gemm g{RB, WUP, 1024, 1024, 1024}; StaticOrder S; S.init(M, FF, F.G, bx, 1); EpiStore<1, true> E{RC, FF, SSQ2};
        for (int rep = 0; rep < NREP(9); ++rep) gemm_phase<EpiStore<1, true>, StaticOrder, true, true>(F.lds, g, S, E);
        if (BOTH(9)) GRID_BAR();
    }
    if (IN(10)) {
        Gemm g{RC, WDN, 64, FF, FF, (size_t)32768, (size_t)(FF / 64) * 32768};     StaticOrder S; S.init(M, D, F.G, bx); EpiResid<2> E{nullptr, RB, SSQ3, F.out, F.g_fin, (unsigned*)(ws + WS_CNT3)};
        gemm_phase<EpiResid<2>, StaticOrder, true, true>(F.lds, g, S, E);
    }
#undef IN
#undef BOTH
}

extern "C" void kernel_launch(void* const* d_in, const int* in_sizes, int n_in, void* d_out, int out_size, void* d_ws, size_t ws_size, hipStream_t stream) {
    static int grid = 0;
    if (grid == 0) {
        if (n_in != 21 || in_sizes[0] != M * D || out_size != M * D || ws_size < WS_END) { fprintf(stderr, "kernel_launch: unexpected shapes (n_in %d, in0 %d, out %d, ws %zu); nothing launched\n", n_in, n_in > 0 ? in_sizes[0] : -1, out_size, ws_size); grid = -1; return; }
        int dev = 0, cus = 0, per_cu = 0;
        if (hipGetDevice(&dev) != hipSuccess || hipDeviceGetAttribute(&cus, hipDeviceAttributeMultiprocessorCount, dev) != hipSuccess) { fprintf(stderr, "kernel_launch: device query failed\n"); grid = -1; return; }
        if (hipFuncSetAttribute((const void*)hymba_fwd, hipFuncAttributeMaxDynamicSharedMemorySize, LDS_BYTES) != hipSuccess) { fprintf(stderr, "kernel_launch: hipFuncSetAttribute failed\n"); grid = -1; return; }
        if (hipOccupancyMaxActiveBlocksPerMultiprocessor(&per_cu, (const void*)hymba_fwd, NWAVES * 64, LDS_BYTES) != hipSuccess || per_cu < 1) { fprintf(stderr, "kernel_launch: occupancy query reports %d blocks per CU\n", per_cu); per_cu = 1; }
        (void)hipGetLastError();
        grid = cus;
    }
    if (grid < 0) return;
    if (hipMemsetAsync((char*)d_ws + WS_CTL, 0, CTL_ZERO_BYTES, stream) != hipSuccess) { fprintf(stderr, "kernel_launch: memset failed\n"); return; }
    Args a{};
    for (int i = 0; i < 21; ++i) a.in[i] = (const float*)d_in[i];
    a.out = (float*)d_out; a.ws = (unsigned char*)d_ws;
    for (int li = 0; li < N_LAUNCHES; ++li) {
        a.ph_lo = (N_LAUNCHES == 1) ? 0 : li; a.ph_hi = (N_LAUNCHES == 1) ? N_PHASES : li + 1; a.li = li;
        hipLaunchKernelGGL(hymba_fwd, dim3(grid), dim3(NWAVES * 64), LDS_BYTES, stream, a);
        const hipError_t le = hipPeekAtLastError();
        if (le != hipSuccess) { fprintf(stderr, "kernel_launch: launch %d failed: %s\n", li, hipGetErrorName(le)); break; }
    }
}
```
